# Optimizing an MI355X kernel written in HIP

```python
import jax, jax.numpy as jnp
from jax import lax
import numpy as np

D_MODEL = 1024
BATCH = 8
SEQ = 8192
DEPTH = 2

CTX_LEN = 256
GRID_W = 64
HG_HEADS = 4
HG_DK = 128
HG_DV = 128
HG_WIDTH = HG_HEADS * HG_DK
POOL_WINDOWS = (2, 4, 8, 16)
POOL_GROUPS = len(POOL_WINDOWS)
POOL_WIDTH = 512
POOL_GD = POOL_WIDTH // POOL_GROUPS
D_FF = 2816
CHUNK = 64
N_MOD = 9
EPS = 1e-6
IN_SIZES = (HG_WIDTH, HG_WIDTH, HG_WIDTH, HG_HEADS * HG_DV, HG_HEADS * HG_DV, POOL_WIDTH, D_MODEL, D_MODEL)
IN_COLS = sum(IN_SIZES)
IN_SPLITS = tuple(int(s) for s in np.cumsum(IN_SIZES)[:-1])

kernel_name = 'hgrn2_pool_macaron_hybrid'


def rmsnorm(x, w):
    xf = x.astype(jnp.float32)
    y = xf * lax.rsqrt(jnp.mean(xf * xf, axis=-1, keepdims=True) + EPS)
    return (y * w.astype(jnp.float32)).astype(x.dtype)


def modulate(x, shift, scale):
    return x * (1 + scale) + shift


def ffn_half(h, mod, k0, norm_w, wg, wu, wd):
    u = modulate(rmsnorm(h, norm_w), mod[:, k0, None], mod[:, k0 + 1, None])
    y = (jax.nn.silu(u @ wg) * (u @ wu)) @ wd
    return h + 0.5 * mod[:, k0 + 2, None] * y


def gla_scan(q, k, v, log_f, s0):
    b, n, h, _ = q.shape
    nc = n // CHUNK

    def to_chunks(t):
        return jnp.moveaxis(t.astype(jnp.float32).reshape(b, nc, CHUNK, h, t.shape[-1]), 1, 0)

    mask = jnp.tril(jnp.ones((CHUNK, CHUNK), dtype=bool))

    def step(state, inp):
        qc, kc, vc, lf = inp
        cum = jnp.cumsum(lf, axis=1)
        inter = jnp.einsum('bchd,bhde->bche', qc * jnp.exp(cum), state)
        diff = cum[:, :, None] - cum[:, None]
        decay = jnp.exp(jnp.where(mask[None, :, :, None, None], diff, -jnp.inf))
        attn = jnp.einsum('btshd,bshd->bhts', qc[:, :, None] * decay, kc)
        intra = jnp.einsum('bhts,bshe->bthe', attn, vc)
        last = cum[:, -1]
        k_dec = kc * jnp.exp(last[:, None] - cum)
        new_state = jnp.exp(last)[..., None] * state + jnp.einsum('bshd,bshe->bhde', k_dec, vc)
        return new_state, inter + intra

    s_fin, out = lax.scan(step, s0, (to_chunks(q), to_chunks(k), to_chunks(v), to_chunks(log_f)))
    out = jnp.moveaxis(out, 0, 1).reshape(b, n, h, v.shape[-1])
    return out, s_fin


def hgrn2_bidir(q, i, zf, zb, lb_f, lb_b, s0_f, s0_b):
    b, n, _ = q.shape

    def heads(t):
        return t.astype(jnp.float32).reshape(b, n, HG_HEADS, -1)

    qh = jax.nn.silu(heads(q))
    vh = heads(i)

    def gates(z, lb):
        z = heads(z)
        lb = lb.astype(jnp.float32).reshape(HG_HEADS, HG_DK)
        f = lb + (1 - lb) * jax.nn.sigmoid(z)
        return (1 - lb) * jax.nn.sigmoid(-z), jnp.log(f)

    kf, lff = gates(zf, lb_f)
    kb, lfb = gates(zb, lb_b)
    o_f, s_f = gla_scan(qh, kf, vh, lff, s0_f)
    flip = lambda t: jnp.flip(t, axis=1)
    o_b, s_b = gla_scan(flip(qh), flip(kb), flip(vh), flip(lfb), s0_b)
    return o_f + flip(o_b), s_f, s_b


def box_mean(x, axis, w):
    length = x.shape[axis]
    cs = jnp.cumsum(x, axis=axis)
    cs = jnp.concatenate([jnp.zeros_like(lax.slice_in_dim(cs, 0, 1, axis=axis)), cs], axis=axis)
    idx = jnp.arange(length)
    lo = jnp.clip(idx - w // 2, 0, length)
    hi = jnp.clip(idx + w - w // 2, 0, length)
    s = jnp.take(cs, hi, axis=axis) - jnp.take(cs, lo, axis=axis)
    shape = [1] * x.ndim
    shape[axis] = length
    return s / (hi - lo).astype(jnp.float32).reshape(shape)


def pool_mixer(v, pool_w, pool_scale, on_grid):
    b, n, _ = v.shape
    vf = v.astype(jnp.float32)
    if on_grid:
        rows = n // GRID_W
        vf = vf.reshape(b, rows, GRID_W, POOL_WIDTH)
    outs = []
    for gi, w in enumerate(POOL_WINDOWS):
        seg = vf[..., gi * POOL_GD:(gi + 1) * POOL_GD]
        m = box_mean(box_mean(seg, 2, w), 1, w) if on_grid else box_mean(seg, 1, w)
        outs.append(m - seg)
    d = jnp.stack(outs, axis=-2).reshape(b, n, POOL_GROUPS, POOL_GD)
    y = jnp.einsum('bngc,gcd->bngd', d, pool_w.astype(jnp.float32)).reshape(b, n, POOL_WIDTH)
    return (y * pool_scale.astype(jnp.float32)).astype(v.dtype)


def mixer(u, w_in, lb_f, lb_b, hg_norm_w, pool_w, pool_scale, w_a, w_b, w_out, s0_f, s0_b, on_grid, need_out):
    proj = u @ w_in
    q, zf, zb, i, g, pv, ga, gb = jnp.split(proj, IN_SPLITS, axis=-1)
    o, s_f, s_b = hgrn2_bidir(q, i, zf, zb, lb_f, lb_b, s0_f, s0_b)
    if not need_out:
        return None, s_f, s_b
    b, n = u.shape[0], u.shape[1]
    on = o * lax.rsqrt(jnp.mean(o * o, axis=-1, keepdims=True) + EPS)
    on = on * hg_norm_w.astype(jnp.float32).reshape(HG_HEADS, HG_DV)
    a = (on.reshape(b, n, HG_HEADS * HG_DV) * jax.nn.silu(g.astype(jnp.float32))).astype(u.dtype)
    p = pool_mixer(pv, pool_w, pool_scale, on_grid)
    merged = jax.nn.sigmoid(ga) * (a @ w_a) + jax.nn.sigmoid(gb) * (p @ w_b)
    return merged @ w_out, s_f, s_b


def setup_inputs(seed: int = 0) -> dict:
    key = jax.random.key(seed)
    ks = jax.random.split(key, 19)
    nrm = lambda k, shape, s: jax.random.normal(k, shape, jnp.float32) * s
    return {
        'x': nrm(ks[0], (BATCH, SEQ, D_MODEL), 1.0),
        'c': nrm(ks[1], (BATCH, D_MODEL), 1.0),
        'ctx': nrm(ks[2], (BATCH, CTX_LEN, D_MODEL), 1.0),
        'c_ctx': nrm(ks[3], (D_MODEL,), 1.0),
        'ada_w': nrm(ks[4], (DEPTH, D_MODEL, N_MOD * D_MODEL), D_MODEL ** -0.5),
        'ada_b': nrm(ks[5], (DEPTH, N_MOD * D_MODEL), 0.02),
        'norm_w': 1.0 + nrm(ks[6], (DEPTH, 3, D_MODEL), 0.02),
        'ffn_wg': nrm(ks[7], (DEPTH, 2, D_MODEL, D_FF), D_MODEL ** -0.5),
        'ffn_wu': nrm(ks[8], (DEPTH, 2, D_MODEL, D_FF), D_MODEL ** -0.5),
        'ffn_wd': nrm(ks[9], (DEPTH, 2, D_FF, D_MODEL), D_FF ** -0.5),
        'w_in': nrm(ks[10], (DEPTH, D_MODEL, IN_COLS), D_MODEL ** -0.5),
        'lower_bounds': nrm(ks[11], (2, DEPTH, HG_WIDTH), 0.5),
        'hg_norm_w': 1.0 + nrm(ks[12], (DEPTH, HG_HEADS * HG_DV), 0.02),
        'pool_w': nrm(ks[13], (DEPTH, POOL_GROUPS, POOL_GD, POOL_GD), POOL_GD ** -0.5),
        'pool_scale': 1.0 + nrm(ks[14], (DEPTH, POOL_WIDTH), 0.02),
        'w_branch_a': nrm(ks[15], (DEPTH, HG_HEADS * HG_DV, D_MODEL), (HG_HEADS * HG_DV) ** -0.5),
        'w_branch_b': nrm(ks[16], (DEPTH, POOL_WIDTH, D_MODEL), POOL_WIDTH ** -0.5),
        'w_out': nrm(ks[17], (DEPTH, D_MODEL, D_MODEL), D_MODEL ** -0.5),
        'final_norm_w': 1.0 + nrm(ks[18], (D_MODEL,), 0.02),
    }


def reference(x, c, ctx, c_ctx, ada_w, ada_b, norm_w, ffn_wg, ffn_wu, ffn_wd, w_in, lower_bounds,
              hg_norm_w, pool_w, pool_scale, w_branch_a, w_branch_b, w_out, final_norm_w):
    b = x.shape[0]
    h, hc = x, ctx
    silu_c = jax.nn.silu(c)
    silu_cc = jax.nn.silu(c_ctx)[None]
    sm = jax.nn.softmax(lower_bounds.astype(jnp.float32), axis=1)
    lbs = jnp.cumsum(sm, axis=1) - sm[:, :1]
    zeros_state = jnp.zeros((b, HG_HEADS, HG_DK, HG_DV), jnp.float32)
    for l in range(DEPTH):
        last = l == DEPTH - 1
        mod_lat = (silu_c @ ada_w[l] + ada_b[l]).reshape(b, N_MOD, D_MODEL)
        mod_ctx = (silu_cc @ ada_w[l] + ada_b[l]).reshape(1, N_MOD, D_MODEL)
        mix_args = (w_in[l], lbs[0, l], lbs[1, l], hg_norm_w[l], pool_w[l], pool_scale[l],
                    w_branch_a[l], w_branch_b[l], w_out[l])
        h = ffn_half(h, mod_lat, 0, norm_w[l, 0], ffn_wg[l, 0], ffn_wu[l, 0], ffn_wd[l, 0])
        hc = ffn_half(hc, mod_ctx, 0, norm_w[l, 0], ffn_wg[l, 0], ffn_wu[l, 0], ffn_wd[l, 0])
        uc = modulate(rmsnorm(hc, norm_w[l, 1]), mod_ctx[:, 3, None], mod_ctx[:, 4, None])
        y_c, s_f, s_b = mixer(uc, *mix_args, zeros_state, zeros_state, False, not last)
        u = modulate(rmsnorm(h, norm_w[l, 1]), mod_lat[:, 3, None], mod_lat[:, 4, None])
        y, _, _ = mixer(u, *mix_args, s_f, s_b, True, True)
        h = h + mod_lat[:, 5, None] * y
        h = ffn_half(h, mod_lat, 6, norm_w[l, 2], ffn_wg[l, 1], ffn_wu[l, 1], ffn_wd[l, 1])
        if not last:
            hc = hc + mod_ctx[:, 5, None] * y_c
            hc = ffn_half(hc, mod_ctx, 6, norm_w[l, 2], ffn_wg[l, 1], ffn_wu[l, 1], ffn_wd[l, 1])
    return rmsnorm(h, final_norm_w)
```

```cpp
#include <hip/hip_runtime.h>
#include <hip/hip_cooperative_groups.h>
#include <cstdio>
namespace cg = cooperative_groups;

#define LAS __attribute__((address_space(3)))
typedef unsigned short bf16_t;
typedef short bf16x8 __attribute__((ext_vector_type(8)));
typedef float f32x4 __attribute__((ext_vector_type(4)));
typedef unsigned u32x4 __attribute__((ext_vector_type(4)));
typedef unsigned u32x2 __attribute__((ext_vector_type(2)));

constexpr int D = 1024, NB = 8, SEQ = 8192, CTX = 256, NLAT = NB * SEQ, NCTX = NB * CTX, MROWS = NLAT + NCTX;
constexpr int DFF = 2816, INC = 5120, HW = 512, NMOD = 9, MODW = NMOD * D;
constexpr float EPS = 1e-6f;
constexpr int PC_Q = 0, PC_ZF = 512, PC_ZB = 1024, PC_I = 1536, PC_G = 2048, PC_PV = 2560, PC_GA = 3072, PC_GB = 4096;
constexpr int PC_D = 0;
constexpr int PC_A = 512;
constexpr int NTHREADS = 512, NWAVES = 8;
constexpr int LDS_MAIN = 131072, LDS_BYTES = LDS_MAIN + 256;
constexpr int KSPLIT = 16;

constexpr size_t SZ_WUP = (size_t)2 * DFF * D * 2, SZ_WDN = (size_t)D * DFF * 2, SZ_WIN = (size_t)INC * D * 2, SZ_WA = (size_t)D * HW * 2, SZ_WOUT = (size_t)D * D * 2;
constexpr size_t OFF_WUP = 0;
constexpr size_t OFF_WDN = OFF_WUP + 4 * SZ_WUP;
constexpr size_t OFF_WIN = OFF_WDN + 4 * SZ_WDN;
constexpr size_t OFF_WA = OFF_WIN + 2 * SZ_WIN;
constexpr size_t OFF_WE = OFF_WA + 2 * SZ_WA;
constexpr size_t OFF_WOUT = OFF_WE + 2 * SZ_WA;
constexpr size_t OFF_MODP = OFF_WOUT + 2 * SZ_WOUT;
constexpr size_t SZ_MODP = (size_t)KSPLIT * 2 * 9 * MODW * 4;
constexpr size_t OFF_MOD = OFF_MODP + SZ_MODP;
constexpr size_t SZ_MOD = (size_t)2 * 9 * MODW * 4;
constexpr size_t OFF_HC = OFF_MOD + SZ_MOD;
constexpr size_t SZ_HC = (size_t)NCTX * D * 4;
constexpr size_t OFF_U = OFF_HC + SZ_HC;
constexpr size_t SZ_U = (size_t)MROWS * D * 2;
constexpr size_t OFF_PROJ = OFF_U + SZ_U;
constexpr size_t SZ_PROJ = (size_t)MROWS * INC * 2;
constexpr int NSEG = 12, SEGCH = 22;
constexpr size_t OFF_SEGU = OFF_PROJ + SZ_PROJ;
constexpr size_t SZ_SEGU = (size_t)64 * (NSEG - 1) * 16384 * 4;
constexpr size_t OFF_SEGD = OFF_SEGU + SZ_SEGU;
constexpr size_t SZ_SEGD = (size_t)64 * (NSEG - 1) * 128 * 4;
constexpr size_t OFF_BAR = OFF_SEGD + SZ_SEGD;
constexpr size_t SZ_BAR = 16384;
constexpr size_t OFF_RSS = OFF_BAR + SZ_BAR;
constexpr size_t SZ_RSS = (size_t)7 * MROWS * 4;
constexpr size_t OFF_NWSC = OFF_RSS + SZ_RSS;
constexpr size_t SZ_NWSC = (size_t)7 * 9 * D * 4;
constexpr int NBIAS = 2 * DFF;
constexpr size_t OFF_BIAS = OFF_NWSC + SZ_NWSC;
constexpr size_t SZ_BIAS = (size_t)6 * 9 * NBIAS * 4;
constexpr size_t WS_END = OFF_BIAS + SZ_BIAS;
static_assert(WS_END <= ((size_t)1 << 30), "workspace must fit 1 GiB");
static_assert((MROWS / 256) % 8 == 0 && (NLAT / 256) % 8 == 0, "row-tile counts must be multiples of the 8-tile row group");

typedef __bf16 bf16x2_t __attribute__((ext_vector_type(2)));
typedef float f32x2_t __attribute__((ext_vector_type(2)));
__device__ __forceinline__ unsigned pk2(float lo, float hi) { f32x2_t v = {lo, hi}; bf16x2_t r = __builtin_convertvector(v, bf16x2_t); return __builtin_bit_cast(unsigned, r); }
__device__ __forceinline__ bf16_t f2bf(float x) { return (bf16_t)(pk2(x, 0.f) & 0xffffu); }
__device__ __forceinline__ float bf2f(bf16_t b) { return __uint_as_float(((unsigned)b) << 16); }
__device__ __forceinline__ float bflo(unsigned w) { return __uint_as_float(w << 16); }
__device__ __forceinline__ float bfhi(unsigned w) { return __uint_as_float(w & 0xffff0000u); }
__device__ __forceinline__ float fexp2(float x) { return __builtin_amdgcn_exp2f(x); }
__device__ __forceinline__ float frcp(float x) { return __builtin_amdgcn_rcpf(x); }
__device__ __forceinline__ float sigm(float x) { return frcp(1.f + __expf(-x)); }
__device__ __forceinline__ float siluf(float x) { return x * frcp(1.f + __expf(-x)); }
__device__ __forceinline__ float wave_sum(float v) {
#pragma unroll
    for (int o = 1; o < 64; o <<= 1) v += __shfl_xor(v, o);
    return v;
}
#define LDS_WAIT() asm volatile("s_waitcnt lgkmcnt(0)" ::: "memory")
__device__ __forceinline__ int otid() { int t = threadIdx.x; asm volatile("" : "+v"(t)); return t; }

namespace pg8 {
constexpr int BM = 256, BK = 64, HALF = 128, HTB = HALF * BK * 2, STAGE_BYTES = 8 * HTB, NXCD = 8, WGM = 8;
__host__ __device__ __forceinline__ int lds_byte(int r, int c) { const int st = (r >> 4) * 2 + (c >> 5), rr = r & 15, cc = c & 31, ob = rr * 64 + cc * 2; return st * 1024 + (ob ^ (((ob >> 9) & 1) << 5)); }
__host__ __device__ __forceinline__ void stage_rc(int b, int& R, int& C) { const int st = b / 1024, sb = b % 1024, swz = sb ^ (((sb >> 9) & 1) << 5); R = (st >> 1) * 16 + swz / 64; C = (st & 1) * 32 + (swz % 64) / 2; }
__host__ __device__ __forceinline__ int perm32(int rho) { const int n = rho >> 4, i = rho & 15; return 8 * (i >> 2) + 4 * n + (i & 3); }

struct Unit { int pm, pn, sub; };
struct Gemm { const char* A; const char* B; long dA, dB; int lda, K; };

template <int NSUB> struct Sched {
    int nM, nN, nwg, G, c, rev;
    __device__ void init(int M, int N, int G_, int c_, int rev_ = 0) { nM = M / BM; nN = N / BM; nwg = nM * nN; G = G_; c = c_; rev = rev_; }
    __device__ bool next(int i, Unit& u) const {
        const int t = (NSUB == 2) ? (i >> 1) : i; u.sub = (NSUB == 2) ? (i & 1) : 0;
        const long L = (long)t * G + c; if (L >= nwg) return false;
        int wgid = (int)L; { const int q = nwg / NXCD, r = nwg % NXCD, xcd = wgid % NXCD, off = wgid / NXCD; wgid = (xcd < r ? xcd * (q + 1) : r * (q + 1) + (xcd - r) * q) + off; }
        const int nig = WGM * nN, gid = wgid / nig, fm = gid * WGM;
        const int pm = fm + ((wgid % nig) % WGM); u.pm = rev ? nM - 1 - pm : pm; u.pn = (wgid % nig) / WGM; return true;
    }
};

template <class Epi, class SchedT>
__device__ __forceinline__ void gemm_phase(LAS unsigned char* lds, const Gemm g, const SchedT& S, const Epi& E) {
    const int tid = otid(), wid = __builtin_amdgcn_readfirstlane(tid >> 6), lane = tid & 63, wr = wid >> 2, wc = wid & 3, fr = lane & 15, fq = lane >> 4;
    const int K = g.K, nt = K / BK;
    unsigned voffA0, voffA1, voffB0, voffB1;
    { int R, C; stage_rc(tid * 16, R, C); const int Rb = Epi::PERM ? ((R & ~31) + perm32(R & 31)) : R; voffA0 = (unsigned)(R * g.lda + C) * 2u; voffB0 = (unsigned)(Rb * K + C) * 2u; }
    { int R, C; stage_rc(tid * 16 + 8192, R, C); const int Rb = Epi::PERM ? ((R & ~31) + perm32(R & 31)) : R; voffA1 = (unsigned)(R * g.lda + C) * 2u; voffB1 = (unsigned)(Rb * K + C) * 2u; }
    const size_t kstep = (size_t)(BK * 2);
    const size_t hstepA = (size_t)HALF * g.lda * 2, hstepB = (size_t)HALF * K * 2;
    const size_t tstepA = 2 * hstepA, tstepB = 2 * hstepB;
    const unsigned ldsw = (unsigned)wid * 1024u;
    const int aoff = lds_byte(wr * 64 + fr, fq * 8), boff = lds_byte(wc * 32 + fr, fq * 8);
#define PG8_SA(b, h) (((b) * 2 + (h)) * HTB)
#define PG8_SB(b, h) ((4 + (b) * 2 + (h)) * HTB)
#define PG8_STAGE(bufoff, gbase, voff) do { \
        __builtin_amdgcn_global_load_lds((const unsigned*)((const char*)(gbase) + voff##0), (LAS unsigned*)(lds + (bufoff) + ldsw), 16, 0, 0); \
        __builtin_amdgcn_global_load_lds((const unsigned*)((const char*)(gbase) + voff##1), (LAS unsigned*)(lds + (bufoff) + ldsw + 8192), 16, 0, 0); } while (0)
#define PG8_LDA(dst, b, h) do { _Pragma("unroll") for (int m = 0; m < 4; ++m) _Pragma("unroll") for (int k = 0; k < 2; ++k) dst[m][k] = *(const LAS bf16x8*)(lds + PG8_SA(b, h) + aoff + m * 2048 + k * 1024); } while (0)
#define PG8_LDB(dst, b, h) do { _Pragma("unroll") for (int n = 0; n < 2; ++n) _Pragma("unroll") for (int k = 0; k < 2; ++k) dst[n][k] = *(const LAS bf16x8*)(lds + PG8_SB(b, h) + boff + n * 2048 + k * 1024); } while (0)
#define PG8_MMA(ai, bj, At, Bt) do { __builtin_amdgcn_s_setprio(1); _Pragma("unroll") for (int m = 0; m < 4; ++m) _Pragma("unroll") for (int n = 0; n < 2; ++n) _Pragma("unroll") for (int k = 0; k < 2; ++k) \
        acc[ai][bj][m][n] = __builtin_amdgcn_mfma_f32_16x16x32_bf16(Bt[n][k], At[m][k], acc[ai][bj][m][n], 0, 0, 0); __builtin_amdgcn_s_setprio(0); } while (0)
#define PG8_WAIT_V(n) asm volatile("s_waitcnt vmcnt(" #n ")" ::: "memory")
#define PG8_WAIT_L(n) asm volatile("s_waitcnt lgkmcnt(" #n ")" ::: "memory")
#define PG8_BAR __builtin_amdgcn_s_barrier()
#define PG8_SCHED __builtin_amdgcn_sched_barrier(0)
    Unit cur, nxt; int ui = 0;
    if (!S.next(0, cur)) return;
    f32x4 acc[2][2][4][2];
#pragma unroll
    for (int a = 0; a < 2; ++a)
#pragma unroll
        for (int b = 0; b < 2; ++b)
#pragma unroll
            for (int m = 0; m < 4; ++m)
#pragma unroll
                for (int n = 0; n < 2; ++n) acc[a][b][m][n] = (f32x4){0.f, 0.f, 0.f, 0.f};
    bf16x8 At[4][2], B0[2][2], B1[2][2];
    const char* cA = g.A + (long)cur.sub * g.dA + (size_t)cur.pm * tstepA; const char* cB = g.B + (long)cur.sub * g.dB + (size_t)cur.pn * tstepB;
    PG8_STAGE(PG8_SB(0, 0), cB, voffB); PG8_STAGE(PG8_SA(0, 0), cA, voffA); PG8_STAGE(PG8_SB(0, 1), cB + hstepB, voffB); PG8_STAGE(PG8_SA(0, 1), cA + hstepA, voffA);
    if (wr == 1) PG8_BAR;
    PG8_WAIT_V(4); PG8_BAR;
    PG8_STAGE(PG8_SB(1, 0), cB + kstep, voffB); PG8_STAGE(PG8_SA(1, 0), cA + kstep, voffA); PG8_STAGE(PG8_SB(1, 1), cB + hstepB + kstep, voffB);
    PG8_WAIT_V(6); PG8_BAR;
    for (;;) {
        const bool has_next = S.next(ui + 1, nxt);
        const char* nA = has_next ? g.A + (long)nxt.sub * g.dA + (size_t)nxt.pm * tstepA : cA; const char* nB = has_next ? g.B + (long)nxt.sub * g.dB + (size_t)nxt.pn * tstepB : cB;
        for (int t = 0; t < nt; t += 2) {
            const bool last = (t == nt - 2);
            const char* a1 = cA + (size_t)(t + 1) * kstep;
            const char* a2 = last ? nA : cA + (size_t)(t + 2) * kstep; const char* b2 = last ? nB : cB + (size_t)(t + 2) * kstep;
            const char* a3 = a2 + kstep; const char* b3 = b2 + kstep;
            PG8_LDB(B0, 0, 0); PG8_SCHED; PG8_LDA(At, 0, 0); PG8_STAGE(PG8_SA(1, 1), a1 + hstepA, voffA);
            PG8_WAIT_L(8); PG8_BAR; PG8_WAIT_L(0); PG8_MMA(0, 0, At, B0); PG8_BAR; PG8_SCHED;
            PG8_LDB(B1, 0, 1); PG8_STAGE(PG8_SB(0, 0), b2, voffB);
            PG8_BAR; PG8_WAIT_L(0); PG8_MMA(0, 1, At, B1); PG8_BAR;
            PG8_LDA(At, 0, 1); PG8_STAGE(PG8_SA(0, 0), a2, voffA);
            PG8_BAR; PG8_WAIT_L(0); PG8_MMA(1, 0, At, B0); PG8_BAR; PG8_SCHED;
            PG8_STAGE(PG8_SB(0, 1), b2 + hstepB, voffB);
            PG8_WAIT_V(6); PG8_BAR; PG8_MMA(1, 1, At, B1); PG8_BAR;
            PG8_LDB(B0, 1, 0); PG8_SCHED; PG8_LDA(At, 1, 0); PG8_STAGE(PG8_SA(0, 1), a2 + hstepA, voffA);
            PG8_WAIT_L(8); PG8_BAR; PG8_WAIT_L(0); PG8_MMA(0, 0, At, B0); PG8_BAR; PG8_SCHED;
            PG8_LDB(B1, 1, 1); PG8_STAGE(PG8_SB(1, 0), b3, voffB);
            PG8_BAR; PG8_WAIT_L(0); PG8_MMA(0, 1, At, B1); PG8_BAR;
            PG8_LDA(At, 1, 1); PG8_STAGE(PG8_SA(1, 0), a3, voffA);
            PG8_BAR; PG8_WAIT_L(0); PG8_MMA(1, 0, At, B0); PG8_BAR; PG8_SCHED;
            PG8_STAGE(PG8_SB(1, 1), b3 + hstepB, voffB);
            PG8_WAIT_V(6); PG8_BAR; PG8_MMA(1, 1, At, B1); PG8_BAR;
        }
        const bool keep = E(acc, cur, wr, wc, fr, fq);
        if (!has_next) break;
        if (!keep) {
#pragma unroll
            for (int a = 0; a < 2; ++a)
#pragma unroll
                for (int b = 0; b < 2; ++b)
#pragma unroll
                    for (int m = 0; m < 4; ++m)
#pragma unroll
                        for (int n = 0; n < 2; ++n) acc[a][b][m][n] = (f32x4){0.f, 0.f, 0.f, 0.f};
        }
        cur = nxt; cA = nA; cB = nB; ++ui;
    }
    PG8_WAIT_V(0);
    if (wr == 0) PG8_BAR;
    PG8_BAR;
#undef PG8_SA
#undef PG8_SB
#undef PG8_STAGE
#undef PG8_LDA
#undef PG8_LDB
#undef PG8_MMA
#undef PG8_WAIT_V
#undef PG8_WAIT_L
#undef PG8_BAR
#undef PG8_SCHED
}

struct EpiUp {
    static constexpr bool PERM = true;
    bf16_t* act; const float* rss; const float* bias;
    __device__ __forceinline__ bool operator()(f32x4 (&acc)[2][2][4][2], const Unit& u, int wr, int wc, int fr, int fq) const {
        const int row0 = u.pm * BM + wr * 64 + fr, hid0 = u.pn * 128 + wc * 32 + 8 * fq, mi = u.pm < (NLAT / BM) ? (u.pm >> 5) : 8;
        const float* bp = bias + (size_t)mi * NBIAS + u.pn * BM + wc * 32 + 8 * fq;
        const f32x4 bg0 = *(const f32x4*)(bp), bg1 = *(const f32x4*)(bp + 4), bu0 = *(const f32x4*)(bp + HALF), bu1 = *(const f32x4*)(bp + HALF + 4);
        float rs[2][4];
#pragma unroll
        for (int ai = 0; ai < 2; ++ai)
#pragma unroll
            for (int m = 0; m < 4; ++m) rs[ai][m] = rss[row0 + ai * HALF + m * 16];
#pragma unroll
        for (int ai = 0; ai < 2; ++ai)
#pragma unroll
            for (int m = 0; m < 4; ++m) { const int row = row0 + ai * HALF + m * 16; const float rr = rsqrtf(rs[ai][m] * (1.f / D) + EPS);
                const f32x4 g0 = acc[ai][0][m][0] * rr + bg0, g1 = acc[ai][0][m][1] * rr + bg1, u0 = acc[ai][1][m][0] * rr + bu0, u1 = acc[ai][1][m][1] * rr + bu1;
                u32x4 w; w.x = pk2(siluf(g0[0]) * u0[0], siluf(g0[1]) * u0[1]); w.y = pk2(siluf(g0[2]) * u0[2], siluf(g0[3]) * u0[3]);
                w.z = pk2(siluf(g1[0]) * u1[0], siluf(g1[1]) * u1[1]); w.w = pk2(siluf(g1[2]) * u1[2], siluf(g1[3]) * u1[3]);
                *(u32x4*)(act + (size_t)row * DFF + hid0) = w; }
        return false;
    }
};
template <bool CHALF, bool SRCF32, bool WRHS = true> struct EpiRes {
    static constexpr bool PERM = true;
    const void* src_lat; long src_dctx; bf16_t* dst_lat; long dst_dctx; const float* modv; bf16_t* hs; const float* nwsc; float* rss;
    __device__ __forceinline__ bool operator()(f32x4 (&acc)[2][2][4][2], const Unit& u, int wr, int wc, int fr, int fq) const {
        const bool isl = u.pm < (NLAT / BM); const int mi = isl ? (u.pm >> 5) : 8;
        const size_t rbase = (size_t)(isl ? u.pm : u.pm - NLAT / BM) * BM + wr * 64 + fr;
        const int col0 = u.pn * BM + wc * 32 + 8 * fq;
        constexpr int HLD = 2 * D;
        constexpr int SLD = SRCF32 ? D : HLD;
        const char* sp = (const char*)src_lat + (isl ? 0L : src_dctx) + (rbase * SLD + col0) * (SRCF32 ? 4 : 2);
        bf16_t* dp = (bf16_t*)((char*)dst_lat + (isl ? 0L : dst_dctx)) + rbase * HLD + col0;
        bf16_t* hp = hs + ((size_t)u.pm * BM + wr * 64 + fr) * D + col0; float* rp = rss + (size_t)u.pm * BM + wr * 64 + fr;
        const float* mv = modv + (size_t)mi * MODW + col0; const float* np = nwsc + (size_t)mi * D + col0;
        f32x4 gq[2][2], nq[2];
#pragma unroll
        for (int bj = 0; bj < 2; ++bj) { gq[bj][0] = *(const f32x4*)(mv + bj * HALF) * (CHALF ? 0.5f : 1.0f); gq[bj][1] = *(const f32x4*)(mv + bj * HALF + 4) * (CHALF ? 0.5f : 1.0f); }
        nq[0] = *(const f32x4*)(np); nq[1] = *(const f32x4*)(np + 4);
        auto finish = [&](int b, const f32x4 (&d0)[2], const f32x4 (&d1)[2]) { const int bj = b >> 2, ai = (b >> 1) & 1, mh = b & 1;
#pragma unroll
            for (int mm = 0; mm < 2; ++mm) { const int m = 2 * mh + mm; const size_t ro = (size_t)(ai * HALF + m * 16) * D + bj * HALF, rh = (size_t)(ai * HALF + m * 16) * HLD + bj * HALF;
                const f32x4 o0 = d0[mm] + gq[bj][0] * acc[ai][bj][m][0], o1 = d1[mm] + gq[bj][1] * acc[ai][bj][m][1];
                u32x4 w; w.x = pk2(o0[0], o0[1]); w.y = pk2(o0[2], o0[3]); w.z = pk2(o1[0], o1[1]); w.w = pk2(o1[2], o1[3]);
                *(u32x4*)(dp + rh) = w;
                const f32x4 r0 = (f32x4){bflo(w.x), bfhi(w.x), bflo(w.y), bfhi(w.y)}, r1 = (f32x4){bflo(w.z), bfhi(w.z), bflo(w.w), bfhi(w.w)};
                acc[ai][bj][m][0] = r0; acc[ai][bj][m][1] = r1;
                if (WRHS) { const f32x4 h0 = r0 * nq[0], h1 = r1 * nq[1]; u32x4 hw; hw.x = pk2(h0[0], h0[1]); hw.y = pk2(h0[2], h0[3]); hw.z = pk2(h1[0], h1[1]); hw.w = pk2(h1[2], h1[3]);
                    *(u32x4*)(hp + ro) = hw; } } };
        if constexpr (SRCF32) {
#pragma unroll
            for (int b = 0; b < 8; ++b) { const int bj = b >> 2, ai = (b >> 1) & 1, mh = b & 1; f32x4 d0[2], d1[2];
                if (b == 4 && WRHS) { nq[0] = *(const f32x4*)(np + HALF); nq[1] = *(const f32x4*)(np + HALF + 4); }
#pragma unroll
                for (int mm = 0; mm < 2; ++mm) { const size_t ro = (size_t)(ai * HALF + (2 * mh + mm) * 16) * SLD + bj * HALF; d0[mm] = *(const f32x4*)(sp + ro * 4); d1[mm] = *(const f32x4*)(sp + ro * 4 + 16); }
                finish(b, d0, d1); }
        } else {
            u32x4 raw[2][2];
#pragma unroll
            for (int mm = 0; mm < 2; ++mm) raw[0][mm] = *(const u32x4*)(sp + ((size_t)(mm * 16) * SLD) * 2);
#pragma unroll
            for (int b = 0; b < 8; ++b) {
                if (b < 7) { const int bj2 = (b + 1) >> 2, ai2 = ((b + 1) >> 1) & 1, mh2 = (b + 1) & 1;
#pragma unroll
                    for (int mm = 0; mm < 2; ++mm) raw[(b + 1) & 1][mm] = *(const u32x4*)(sp + ((size_t)(ai2 * HALF + (2 * mh2 + mm) * 16) * SLD + bj2 * HALF) * 2); }
                if (b == 4 && WRHS) { nq[0] = *(const f32x4*)(np + HALF); nq[1] = *(const f32x4*)(np + HALF + 4); }
                f32x4 d0[2], d1[2];
#pragma unroll
                for (int mm = 0; mm < 2; ++mm) { const u32x4 w = raw[b & 1][mm]; d0[mm] = (f32x4){bflo(w[0]), bfhi(w[0]), bflo(w[1]), bfhi(w[1])}; d1[mm] = (f32x4){bflo(w[2]), bfhi(w[2]), bflo(w[3]), bfhi(w[3])}; }
                finish(b, d0, d1); }
        }
#pragma unroll
        for (int ai = 0; ai < 2; ++ai)
#pragma unroll
            for (int m = 0; m < 4; ++m) { float v = 0.f;
#pragma unroll
                for (int bj = 0; bj < 2; ++bj)
#pragma unroll
                    for (int n = 0; n < 2; ++n) { const f32x4 o = acc[ai][bj][m][n]; v += (o[0] * o[0] + o[1] * o[1]) + (o[2] * o[2] + o[3] * o[3]); }
                v += __shfl_xor(v, 16); v += __shfl_xor(v, 32);
                if (fq == 0) atomicAdd(rp + ai * HALF + m * 16, v); }
        return false;
    }
};
struct EpiProj {
    static constexpr bool PERM = true;
    bf16_t* O; int ldc; const float* rss; const float* bias;
    __device__ __forceinline__ bool operator()(f32x4 (&acc)[2][2][4][2], const Unit& u, int wr, int wc, int fr, int fq) const {
        const int row0 = u.pm * BM + wr * 64 + fr, col0 = u.pn * BM + wc * 32 + 8 * fq, mi = u.pm < (NLAT / BM) ? (u.pm >> 5) : 8;
        const float* bp = bias + (size_t)mi * NBIAS + col0;
        const bool qsilu = u.pn * BM < PC_ZF;
        float rr[2][4];
#pragma unroll
        for (int ai = 0; ai < 2; ++ai)
#pragma unroll
            for (int m = 0; m < 4; ++m) rr[ai][m] = rsqrtf(rss[row0 + ai * HALF + m * 16] * (1.f / D) + EPS);
#pragma unroll
        for (int bj = 0; bj < 2; ++bj) { const f32x4 b0 = *(const f32x4*)(bp + bj * HALF), b1 = *(const f32x4*)(bp + bj * HALF + 4);
#pragma unroll
            for (int ai = 0; ai < 2; ++ai)
#pragma unroll
                for (int m = 0; m < 4; ++m) { bf16_t* rowp = O + (size_t)(row0 + ai * HALF + m * 16) * ldc + col0;
                    f32x4 v0 = acc[ai][bj][m][0] * rr[ai][m] + b0, v1 = acc[ai][bj][m][1] * rr[ai][m] + b1;
                    if (qsilu) {
#pragma unroll
                        for (int j = 0; j < 4; ++j) { v0[j] = siluf(v0[j]); v1[j] = siluf(v1[j]); } }
                    u32x4 w; w.x = pk2(v0[0], v0[1]); w.y = pk2(v0[2], v0[3]); w.z = pk2(v1[0], v1[1]); w.w = pk2(v1[2], v1[3]);
                    *(u32x4*)(rowp + bj * HALF) = w; } }
        return false;
    }
};
struct EpiMerge {
    static constexpr bool PERM = true;
    const bf16_t* proj; bf16_t* merged; int ldm;
    __device__ __forceinline__ bool operator()(f32x4 (&acc)[2][2][4][2], const Unit& u, int wr, int wc, int fr, int fq) const {
        const int row0 = u.pm * BM + wr * 64 + fr, col0 = u.pn * BM + wc * 32 + 8 * fq;
        if (u.sub == 0) {
#pragma unroll
            for (int ai = 0; ai < 2; ++ai)
#pragma unroll
                for (int bj = 0; bj < 2; ++bj) { u32x4 gaq[4], gbq[4];
#pragma unroll
                    for (int m = 0; m < 4; ++m) { const bf16_t* pr = proj + (size_t)(row0 + ai * HALF + m * 16) * INC + col0 + bj * HALF; gaq[m] = *(const u32x4*)(pr + PC_GA); gbq[m] = *(const u32x4*)(pr + PC_GB); }
#pragma unroll
                    for (int m = 0; m < 4; ++m) { const u32x4 gaw = gaq[m], gbw = gbq[m];
#pragma unroll
                        for (int k = 0; k < 4; ++k) { const int n = k >> 1, j = (k & 1) * 2;
                            acc[ai][bj][m][n][j] *= (1.f + __expf(-bflo(gbw[k]))) * frcp(1.f + __expf(-bflo(gaw[k])));
                            acc[ai][bj][m][n][j + 1] *= (1.f + __expf(-bfhi(gbw[k]))) * frcp(1.f + __expf(-bfhi(gaw[k]))); } } }
            return true;
        }
#pragma unroll
        for (int ai = 0; ai < 2; ++ai) {
            u32x4 gb[4][2];
#pragma unroll
            for (int m = 0; m < 4; ++m)
#pragma unroll
                for (int bj = 0; bj < 2; ++bj) gb[m][bj] = *(const u32x4*)(proj + (size_t)(row0 + ai * HALF + m * 16) * INC + col0 + PC_GB + bj * HALF);
#pragma unroll
            for (int m = 0; m < 4; ++m)
#pragma unroll
                for (int bj = 0; bj < 2; ++bj) { const u32x4 gbw = gb[m][bj]; float o[8];
#pragma unroll
                    for (int k = 0; k < 4; ++k) { const int n = k >> 1, j = (k & 1) * 2;
                        o[2 * k] = acc[ai][bj][m][n][j] * frcp(1.f + __expf(-bflo(gbw[k]))); o[2 * k + 1] = acc[ai][bj][m][n][j + 1] * frcp(1.f + __expf(-bfhi(gbw[k]))); }
                    u32x4 w; w.x = pk2(o[0], o[1]); w.y = pk2(o[2], o[3]); w.z = pk2(o[4], o[5]); w.w = pk2(o[6], o[7]);
                    *(u32x4*)(merged + (size_t)(row0 + ai * HALF + m * 16) * ldm + col0 + bj * HALF) = w; }
        }
        return false;
    }
};
}

#define XB_TMO      128
#define XB_XCNT(j)  (256  + 64 * (j))
#define XB_XSUB(j)  (1280 + 64 * (j))
#define XB_XGEN(j)  (2304 + 64 * (j))
#define XB_TOP      3328
#define XB_TOPGEN   3392
#define XCD_BAR_WORDS 3456
#define XB_SPIN_CAP (1u << 20)
__device__ __forceinline__ unsigned xb_ld(unsigned* p)              { return __hip_atomic_load(p, __ATOMIC_RELAXED, __HIP_MEMORY_SCOPE_AGENT); }
__device__ __forceinline__ unsigned xb_add(unsigned* p, unsigned v) { return __hip_atomic_fetch_add(p, v, __ATOMIC_RELAXED, __HIP_MEMORY_SCOPE_AGENT); }
__device__ __forceinline__ unsigned xb_xcc_id() { return (unsigned)__builtin_amdgcn_s_getreg((3 << 11) | 20) & 0xFu; }
#define XB_SPIN(cond, bar) do { unsigned _sp = 0; while (cond) { __builtin_amdgcn_s_sleep(1); \
    if ((++_sp & 255u) == 0u) { if (xb_ld(&(bar)[XB_TMO])) break; if (_sp > XB_SPIN_CAP) { atomicAdd(&(bar)[XB_TMO], 1u); break; } } } } while (0)
struct XcdBarrier { unsigned* bar; unsigned x; volatile LAS unsigned* st; };
__device__ __forceinline__ XcdBarrier xcd_barrier_post(unsigned* bar, volatile LAS unsigned* st) {
    XcdBarrier b; b.bar = bar; b.x = xb_xcc_id(); b.st = st;
    if (threadIdx.x == 0) (void)xb_add(&bar[XB_XCNT(b.x)], 1u);
    return b;
}
__device__ __forceinline__ void xcd_barrier_complete(unsigned* bar, unsigned x, unsigned& nloc, unsigned& nx) {
    const unsigned G = gridDim.x * gridDim.y * gridDim.z;
    unsigned sum, cnt, mine, sp = 0u;
    for (;;) {
        sum = 0u; cnt = 0u; mine = 0u;
#pragma unroll
        for (unsigned j = 0; j < 16; ++j) { const unsigned c = xb_ld(&bar[XB_XCNT(j)]); sum += c; cnt += (c > 0u) ? 1u : 0u; mine = (j == x) ? c : mine; }
        if (sum == G) break;
        __builtin_amdgcn_s_sleep(1);
        if ((++sp & 255u) == 0u) { if (xb_ld(&bar[XB_TMO])) break; if (sp > XB_SPIN_CAP) { atomicAdd(&bar[XB_TMO], 1u); break; } }
    }
    nloc = mine > 0u ? mine : 1u; nx = cnt > 0u ? cnt : 1u;
}
__device__ __forceinline__ void xcd_barrier(const XcdBarrier& b) {
    asm volatile("s_waitcnt vmcnt(0)" ::: "memory");
    __syncthreads();
    if (threadIdx.x == 0) {
        unsigned* bar = b.bar;
        __builtin_amdgcn_s_waitcnt(0);
        unsigned nloc = b.st[0], nx = b.st[1];
        if (nloc == 0u) { xcd_barrier_complete(bar, b.x, nloc, nx); b.st[0] = nloc; b.st[1] = nx; }
        const unsigned old = xb_add(&bar[XB_XSUB(b.x)], 1u);
        const unsigned gen = old / nloc;
        if (old + 1u == (gen + 1u) * nloc) {
            __builtin_amdgcn_fence(__ATOMIC_RELEASE, "agent");
            asm volatile("s_waitcnt vmcnt(0)" ::: "memory");
            const unsigned og = xb_add(&bar[XB_TOP], 1u);
            const unsigned tg = og / nx;
            if (og + 1u == (tg + 1u) * nx) xb_add(&bar[XB_TOPGEN], 1u);
            else XB_SPIN(xb_ld(&bar[XB_TOPGEN]) == tg, bar);
            __builtin_amdgcn_fence(__ATOMIC_ACQUIRE, "agent");
            xb_add(&bar[XB_XGEN(b.x)], 1u);
            asm volatile("s_waitcnt vmcnt(0)" ::: "memory");
        } else {
            XB_SPIN(xb_ld(&bar[XB_XGEN(b.x)]) == gen, bar);
            __builtin_amdgcn_fence(__ATOMIC_ACQUIRE, "agent");
            asm volatile("s_waitcnt vmcnt(0)" ::: "memory");
        }
    }
    __syncthreads();
}

struct Args { const float* in[19]; float* out; unsigned char* ws; int lo, hi; };
typedef const __attribute__((address_space(4))) char* kptr_t;
__device__ __forceinline__ kptr_t kargs() { kptr_t p = (kptr_t)__builtin_amdgcn_kernarg_segment_ptr(); asm volatile("" : "+s"(p)); return p; }
#define KIN(i) (*(const float* const __attribute__((address_space(4)))*)(kargs() + 8 * (i)))
#define KOUT (*(float* const __attribute__((address_space(4)))*)(kargs() + 8 * 19))
#define KWS (*(unsigned char* const __attribute__((address_space(4)))*)(kargs() + 8 * 20))
enum { I_X = 0, I_C, I_CTX, I_CCTX, I_ADAW, I_ADAB, I_NORMW, I_WG, I_WU, I_WD, I_WIN, I_LB, I_HGW, I_POOLW, I_POOLS, I_WBA, I_WBB, I_WOUT, I_FNW };

template <class RowMap>
__device__ __forceinline__ void transpose_item(const float* src0, size_t ld, int K, bf16_t* WT, int k0, const RowMap& rm, LAS float* scr, int lane) {
    const float* src = src0 + (lane & 31) + (size_t)(k0 + (lane >> 5)) * ld;
    float tv[32];
#pragma unroll
    for (int i = 0; i < 32; ++i) tv[i] = src[(size_t)(2 * i) * ld];
#pragma unroll
    for (int i = 0; i < 32; ++i) scr[(2 * i + (lane >> 5)) * 33 + (lane & 31)] = tv[i];
    LDS_WAIT();
    const int c = lane & 7;
#pragma unroll
    for (int j = 0; j < 4; ++j) { const int n = (lane >> 3) + 8 * j; const LAS float* s = scr + (8 * c) * 33 + n;
        u32x4 o; o.x = pk2(s[0 * 33], s[1 * 33]); o.y = pk2(s[2 * 33], s[3 * 33]); o.z = pk2(s[4 * 33], s[5 * 33]); o.w = pk2(s[6 * 33], s[7 * 33]);
        *(u32x4*)(WT + (size_t)rm(n) * K + k0 + 8 * c) = o; }
    LDS_WAIT();
}
struct RowPlain { int n0; __device__ __forceinline__ int operator()(int i) const { return n0 + i; } };


__device__ __forceinline__ void prologue_a(LAS unsigned char* lds) {
    const int tid = otid(), lane = tid & 63, wave = tid >> 6, G = gridDim.x;
    unsigned char* ws = KWS;
    LAS float* scr = (LAS float*)(lds + wave * 8704);
    constexpr int IT_UP = (D / 64) * (2 * DFF / 32), IT_DN = (DFF / 64) * (D / 32), IT_IN = (D / 64) * (INC / 32), IT_A = (HW / 64) * (D / 32), IT_OUT = (D / 64) * (D / 32);
    constexpr int IT_LAYER = 2 * IT_UP + 2 * IT_DN + IT_IN + IT_A + IT_OUT;
    for (int it = blockIdx.x * NWAVES + wave; it < 2 * IT_LAYER; it += G * NWAVES) {
        const int l = it / IT_LAYER; int r = it % IT_LAYER;
        if (r < 2 * IT_UP) { const int hh = r / IT_UP; r %= IT_UP; const size_t wo = ((size_t)(l * 2 + hh)) * D * DFF;
            constexpr int nblk = 2 * DFF / 32; const int kb = r / nblk, nb = r % nblk, n0 = 32 * nb, tile = n0 >> 8, cl = n0 & 255, sel = cl >> 7, hcol = 128 * tile + (cl & 127);
            const float* wsrc = (const float*)(sel ? (unsigned long long)KIN(I_WU) : (unsigned long long)KIN(I_WG));
            RowPlain rm{n0}; transpose_item(wsrc + wo + hcol, DFF, D, (bf16_t*)(ws + OFF_WUP + (size_t)(l * 2 + hh) * SZ_WUP), 64 * kb, rm, scr, lane); continue; }
        r -= 2 * IT_UP;
        if (r < 2 * IT_DN) { const int hh = r / IT_DN; r %= IT_DN; constexpr int nblk = D / 32; const int kb = r / nblk, nb = r % nblk;
            RowPlain rm{32 * nb}; transpose_item(KIN(I_WD) + ((size_t)(l * 2 + hh)) * DFF * D + 32 * nb, D, DFF, (bf16_t*)(ws + OFF_WDN + (size_t)(l * 2 + hh) * SZ_WDN), 64 * kb, rm, scr, lane); continue; }
        r -= 2 * IT_DN;
        if (r < IT_IN) { constexpr int nblk = INC / 32; const int kb = r / nblk, nb = r % nblk;
            RowPlain rm{32 * nb}; transpose_item(KIN(I_WIN) + (size_t)l * D * INC + 32 * nb, INC, D, (bf16_t*)(ws + OFF_WIN + (size_t)l * SZ_WIN), 64 * kb, rm, scr, lane); continue; }
        r -= IT_IN;
        if (r < IT_A) { constexpr int nblk = D / 32; const int kb = r / nblk, nb = r % nblk;
            RowPlain rm{32 * nb}; transpose_item(KIN(I_WBA) + (size_t)l * HW * D + 32 * nb, D, HW, (bf16_t*)(ws + OFF_WA + (size_t)l * SZ_WA), 64 * kb, rm, scr, lane); continue; }
        r -= IT_A;
        { constexpr int nblk = D / 32; const int kb = r / nblk, nb = r % nblk;
            RowPlain rm{32 * nb}; transpose_item(KIN(I_WOUT) + (size_t)l * D * D + 32 * nb, D, D, (bf16_t*)(ws + OFF_WOUT + (size_t)l * SZ_WOUT), 64 * kb, rm, scr, lane); }
    }
    { float* rz = (float*)(ws + OFF_RSS); for (int i = blockIdx.x * NTHREADS + tid; i < 7 * MROWS; i += G * NTHREADS) rz[i] = 0.f; }
    { float* nz = (float*)(ws + OFF_NWSC) + 6 * 9 * D; for (int i = blockIdx.x * NTHREADS + tid; i < 9 * D; i += G * NTHREADS) nz[i] = 0.f; }
    __syncthreads();
    {
        LAS float* sv = (LAS float*)lds;
        float* modp = (float*)(ws + OFF_MODP);
        constexpr int NCT = MODW / 512;
        for (int it = blockIdx.x; it < 2 * NCT * KSPLIT; it += G) {
            const int l = it / (NCT * KSPLIT), ct = (it / KSPLIT) % NCT, ks = it % KSPLIT;
            for (int idx = tid; idx < 9 * 64; idx += NTHREADS) { const int mi = idx >> 6, k = ks * 64 + (idx & 63); const float cv = mi < 8 ? KIN(I_C)[mi * D + k] : KIN(I_CCTX)[k]; sv[idx] = siluf(cv); }
            __syncthreads();
            const int col = ct * 512 + tid;
            float acc[9];
#pragma unroll
            for (int mi = 0; mi < 9; ++mi) acc[mi] = 0.f;
            const float* w = KIN(I_ADAW) + ((size_t)l * D + ks * 64) * MODW + col;
#pragma unroll 16
            for (int kk = 0; kk < 64; ++kk) { const float wv = w[(size_t)kk * MODW];
#pragma unroll
                for (int mi = 0; mi < 9; ++mi) acc[mi] += sv[mi * 64 + kk] * wv; }
#pragma unroll
            for (int mi = 0; mi < 9; ++mi) modp[((size_t)(ks * 2 + l) * 9 + mi) * MODW + col] = acc[mi];
            __syncthreads();
        }
    }
    {
        LAS float* pvs = (LAS float*)lds;
        for (int it = blockIdx.x; it < 2 * 4 * 2 * 8; it += G) {
            const int cb = it & 7, nh = (it >> 3) & 1, g = (it >> 4) & 3, l = it >> 6, n = nh * 512 + tid, c0 = g * 128 + cb * 16;
            for (int idx = tid; idx < 16 * 128; idx += NTHREADS) { const int cc = idx >> 7, j = idx & 127;
                pvs[idx] = KIN(I_POOLW)[((size_t)(l * 4 + g) * 128 + cb * 16 + cc) * 128 + j] * KIN(I_POOLS)[l * HW + g * 128 + j]; }
            const float* wb = KIN(I_WBB) + ((size_t)l * HW + g * 128) * D + n;
            __syncthreads();
            float sc[16];
#pragma unroll
            for (int cc = 0; cc < 16; ++cc) sc[cc] = 0.f;
#pragma unroll 1
            for (int jq = 0; jq < 4; ++jq) {
                float wv[32];
#pragma unroll
                for (int j = 0; j < 32; ++j) wv[j] = wb[(size_t)(jq * 32 + j) * D];
#pragma unroll
                for (int cc = 0; cc < 16; ++cc) {
#pragma unroll
                    for (int j4 = 0; j4 < 8; ++j4) { const f32x4 p = *(const LAS f32x4*)(pvs + cc * 128 + jq * 32 + 4 * j4);
                        sc[cc] += (p[0] * wv[4 * j4] + p[1] * wv[4 * j4 + 1]) + (p[2] * wv[4 * j4 + 2] + p[3] * wv[4 * j4 + 3]); } } }
            unsigned pk[8];
#pragma unroll
            for (int cp = 0; cp < 8; ++cp) pk[cp] = pk2(sc[2 * cp], sc[2 * cp + 1]);
            bf16_t* we = (bf16_t*)(ws + OFF_WE + (size_t)l * SZ_WA) + (size_t)n * HW + c0;
            *(u32x4*)we = (u32x4){pk[0], pk[1], pk[2], pk[3]}; *(u32x4*)(we + 8) = (u32x4){pk[4], pk[5], pk[6], pk[7]};
            __syncthreads();
        }
    }
}
__device__ __forceinline__ void prologue_b() {
    unsigned char* ws = KWS; const float* modp = (const float*)(ws + OFF_MODP); float* mod = (float*)(ws + OFF_MOD); float* nwsc = (float*)(ws + OFF_NWSC);
    for (int i = blockIdx.x * NTHREADS + otid(); i < 2 * 9 * MODW; i += gridDim.x * NTHREADS) {
        const int l = i / (9 * MODW), rem = i % (9 * MODW), mi = rem / MODW, col9 = rem % MODW, kidx = col9 / D, col = col9 % D; float s = KIN(I_ADAB)[l * MODW + col9];
#pragma unroll
        for (int ks = 0; ks < KSPLIT; ++ks) s += modp[(size_t)ks * 2 * 9 * MODW + i];
        mod[i] = s;
        if (kidx == 1 || kidx == 4 || kidx == 7) { const int j = kidx / 3; nwsc[((size_t)(l * 3 + j) * 9 + mi) * D + col] = KIN(I_NORMW)[(l * 3 + j) * D + col] * (1.f + s); } }
}
__device__ __forceinline__ void bias_phase(unsigned char* ws) {
    const int tid = otid(), lane = tid & 63, gw = blockIdx.x * NWAVES + (tid >> 6), NGW = gridDim.x * NWAVES;
    const float* mod = (const float*)(ws + OFF_MOD); float* bias = (float*)(ws + OFF_BIAS);
    constexpr int NR = 2 * NBIAS + INC;
    for (int ri = gw; ri < 2 * NR; ri += NGW) {
        const int l = ri / NR, r = ri % NR, j = r < NBIAS ? 0 : (r < NBIAS + INC ? 1 : 2), n = r - (j == 0 ? 0 : (j == 1 ? NBIAS : NBIAS + INC));
        const size_t woff = (j == 1) ? OFF_WIN + (size_t)l * SZ_WIN : OFF_WUP + (size_t)(l * 2 + (j >> 1)) * SZ_WUP;
        const bf16_t* wt = (const bf16_t*)(ws + woff) + (size_t)n * D + lane * 16;
        const u32x4 w0 = *(const u32x4*)wt, w1 = *(const u32x4*)(wt + 8);
        float wv[16];
#pragma unroll
        for (int k = 0; k < 4; ++k) { wv[2 * k] = bflo(w0[k]); wv[2 * k + 1] = bfhi(w0[k]); wv[8 + 2 * k] = bflo(w1[k]); wv[8 + 2 * k + 1] = bfhi(w1[k]); }
        float res[9];
#pragma unroll
        for (int mi = 0; mi < 9; ++mi) { const float* sh = mod + (size_t)(l * 9 + mi) * MODW + (3 * j) * D + lane * 16; float acc = 0.f;
#pragma unroll
            for (int q = 0; q < 4; ++q) { const f32x4 sv = *(const f32x4*)(sh + 4 * q); acc += (sv[0] * wv[4 * q] + sv[1] * wv[4 * q + 1]) + (sv[2] * wv[4 * q + 2] + sv[3] * wv[4 * q + 3]); }
            res[mi] = wave_sum(acc); }
        if (lane == 0) {
#pragma unroll
            for (int mi = 0; mi < 9; ++mi) bias[((size_t)(l * 3 + j) * 9 + mi) * NBIAS + n] = res[mi]; }
    }
}

__device__ __forceinline__ void norm0_phase(const float* src_lat, const float* src_ctx, const float* nwsc, bf16_t* U, float* rss, int nrows) {
    const int tid = otid(), lane = tid & 63, gw = blockIdx.x * NWAVES + (tid >> 6), NGW = gridDim.x * NWAVES;
    for (int row0 = gw; row0 < nrows; row0 += 2 * NGW) {
        f32x4 v[2][4]; int rw[2]; bool ok[2];
#pragma unroll
        for (int q = 0; q < 2; ++q) { const int row = row0 + q * NGW; ok[q] = row < nrows; rw[q] = ok[q] ? row : row0;
            const bool isl = rw[q] < NLAT;
            const f32x4* xr = (const f32x4*)((const char*)src_lat + (isl ? (size_t)rw[q] * D * 4 : ((const char*)src_ctx - (const char*)src_lat) + (size_t)(rw[q] - NLAT) * D * 4)) + lane;
#pragma unroll
            for (int j = 0; j < 4; ++j) v[q][j] = xr[64 * j]; }
#pragma unroll
        for (int q = 0; q < 2; ++q) { float ss = 0.f;
#pragma unroll
            for (int j = 0; j < 4; ++j) ss += (v[q][j].x * v[q][j].x + v[q][j].y * v[q][j].y) + (v[q][j].z * v[q][j].z + v[q][j].w * v[q][j].w);
            ss = wave_sum(ss);
            if (ok[q]) { const int row = rw[q], mi = row < NLAT ? row / SEQ : 8;
                if (lane == 0) rss[row] = ss;
                u32x2* o = (u32x2*)(U + (size_t)row * D) + lane;
#pragma unroll
                for (int j = 0; j < 4; ++j) { const int col = 4 * (lane + 64 * j);
                    const f32x4 uu = v[q][j] * *(const f32x4*)(nwsc + (size_t)mi * D + col);
                    u32x2 pk; pk.x = pk2(uu.x, uu.y); pk.y = pk2(uu.z, uu.w); o[64 * j] = pk; } } }
    }
}
__device__ __forceinline__ void final_norm_phase(float* out, const float* nw, const float* rss) {
    const int tid = otid(), lane = tid & 63, gw = blockIdx.x * NWAVES + (tid >> 6), NGW = gridDim.x * NWAVES;
    f32x4 wv[4];
#pragma unroll
    for (int j = 0; j < 4; ++j) wv[j] = *(const f32x4*)(nw + 4 * (lane + 64 * j));
    for (int row = gw; row < NLAT; row += 2 * NGW) {
        const int row2 = row + NGW; const bool has2 = row2 < NLAT; const int rb = has2 ? row2 : row;
        const u32x2* ha = (const u32x2*)((const bf16_t*)(out + (size_t)row * D) + D) + lane; const u32x2* hb = (const u32x2*)((const bf16_t*)(out + (size_t)rb * D) + D) + lane;
        u32x2 va[4], vb[4];
#pragma unroll
        for (int j = 0; j < 4; ++j) { va[j] = ha[64 * j]; vb[j] = hb[64 * j]; }
        const float ra = rsqrtf(rss[row] * (1.f / D) + EPS), r2 = rsqrtf(rss[rb] * (1.f / D) + EPS);
        asm volatile("s_waitcnt vmcnt(0)" ::: "memory");
        f32x4* oa = (f32x4*)(out + (size_t)row * D) + lane; f32x4* ob = (f32x4*)(out + (size_t)rb * D) + lane;
#pragma unroll
        for (int j = 0; j < 4; ++j) { oa[64 * j] = (f32x4){bflo(va[j].x), bfhi(va[j].x), bflo(va[j].y), bfhi(va[j].y)} * ra * wv[j];
            if (has2) ob[64 * j] = (f32x4){bflo(vb[j].x), bfhi(vb[j].x), bflo(vb[j].y), bfhi(vb[j].y)} * r2 * wv[j]; }
    }
}
__device__ __forceinline__ void a_phase(bf16_t* proj, const bf16_t* OF, const bf16_t* OB, const float* hgw, int nrows) {
    const int tid = otid(), lane = tid & 63, gw = blockIdx.x * NWAVES + (tid >> 6), NGW = gridDim.x * NWAVES;
    const f32x4 w0 = *(const f32x4*)(hgw + lane * 8), w1 = *(const f32x4*)(hgw + lane * 8 + 4);
    for (int row0 = gw; row0 < nrows; row0 += 2 * NGW) {
        u32x4 f[2], b[2], gg[2]; int rw[2]; bool ok[2];
#pragma unroll
        for (int q = 0; q < 2; ++q) { const int row = row0 + q * NGW; ok[q] = row < nrows; rw[q] = ok[q] ? row : row0;
            f[q] = *(const u32x4*)(OF + (size_t)rw[q] * HW + lane * 8); b[q] = *(const u32x4*)(OB + (size_t)rw[q] * HW + lane * 8);
            gg[q] = *(const u32x4*)(proj + (size_t)rw[q] * INC + PC_G + lane * 8); }
#pragma unroll
        for (int q = 0; q < 2; ++q) {
            float o[8], gv[8]; float ss = 0.f;
#pragma unroll
            for (int k = 0; k < 4; ++k) { o[2 * k] = bflo(f[q][k]) + bflo(b[q][k]); o[2 * k + 1] = bfhi(f[q][k]) + bfhi(b[q][k]); gv[2 * k] = bflo(gg[q][k]); gv[2 * k + 1] = bfhi(gg[q][k]); }
#pragma unroll
            for (int k = 0; k < 8; ++k) ss += o[k] * o[k];
            ss += __shfl_xor(ss, 1); ss += __shfl_xor(ss, 2); ss += __shfl_xor(ss, 4); ss += __shfl_xor(ss, 8);
            const float r = rsqrtf(ss * (1.f / 128.f) + EPS);
            float av[8];
#pragma unroll
            for (int k = 0; k < 4; ++k) { av[k] = o[k] * r * w0[k] * siluf(gv[k]); av[4 + k] = o[4 + k] * r * w1[k] * siluf(gv[4 + k]); }
            u32x4 w; w.x = pk2(av[0], av[1]); w.y = pk2(av[2], av[3]); w.z = pk2(av[4], av[5]); w.w = pk2(av[6], av[7]);
            if (ok[q]) *(u32x4*)(proj + (size_t)rw[q] * INC + PC_A + lane * 8) = w; }
    }
}

template <int MODE>
__device__ __forceinline__ void scan_phase(const bf16_t* proj, bf16_t* OF, bf16_t* OB, const float* lower_bounds, int l, LAS unsigned char* lds, float* segU, float* segD) {
    constexpr int C = 32, SD = 272, SS = 80;
    LAS unsigned char* QB = lds;
    LAS unsigned char* QC1 = QB + 32 * SD;
    LAS unsigned char* KD = QC1 + 16 * SD;
    LAS unsigned char* KE0 = KD + 32 * SD;
    LAS unsigned char* KST = KE0 + 16 * SD;
    LAS unsigned char* VT = KST + 128 * SS;
    LAS unsigned char* S0T = VT + 128 * SS;
    LAS unsigned char* ATT = S0T + 128 * SD;
    LAS float* TG = (LAS float*)(ATT + 32 * SS);
    LAS float* DEC = TG + 512;
    const int tid = otid(), lane = tid & 63, w = __builtin_amdgcn_readfirstlane(tid >> 6), q4 = lane >> 4, c = lane & 15;
    const int d = tid & 127, g = tid >> 7, sub = g >> 1, hf = g & 1;
    const int vs = tid & 31, veg = tid >> 5;
    constexpr int NS = (MODE == 0) ? NSEG - 1 : NSEG;
    for (int item = blockIdx.x; item < 64 * NS; item += gridDim.x) {
        const int seq = item / NS, sg = item - seq * NS, b = seq >> 3, h = (seq >> 1) & 3, dir = seq & 1, ch0 = sg * SEGCH;
        float lb = 0.f;
        if (l > 0) { const float a0 = lower_bounds[(dir * 2 + 0) * HW + h * 128 + d], a1 = lower_bounds[(dir * 2 + 1) * HW + h * 128 + d]; lb = 1.f / (1.f + __expf(a0 - a1)); }
        const float oml = 1.f - lb;
        bf16_t* O = (dir ? OB : OF) + h * 128;
        const bf16_t* pq = proj + PC_Q + h * 128 + d;
        const bf16_t* pz = proj + (dir ? PC_ZB : PC_ZF) + h * 128 + d;
        const bf16_t* pv = proj + PC_I + h * 128 + veg * 8;
        auto rowof = [&](int tt) -> size_t {
            if (tt < CTX) { const int idx = dir ? CTX - 1 - tt : tt; return (size_t)NLAT + b * CTX + idx; }
            const int li = tt - CTX, idx = dir ? SEQ - 1 - li : li; return (size_t)b * SEQ + idx; };
        f32x4 S[8];
#pragma unroll
        for (int i = 0; i < 8; ++i) S[i] = (f32x4){0.f, 0.f, 0.f, 0.f};
        float Ltot = 0.f;
        if (MODE == 1) {
            for (int j = 0; j < sg; ++j) {
                const f32x4* uj = (const f32x4*)(segU + ((size_t)(seq * (NSEG - 1) + j) * NTHREADS + tid) * 32);
                const f32x4 dj = *(const f32x4*)(segD + (size_t)(seq * (NSEG - 1) + j) * 128 + 16 * w + 4 * q4);
#pragma unroll
                for (int et = 0; et < 8; ++et) S[et] = S[et] * dj + uj[et];
            }
#pragma unroll
            for (int et = 0; et < 8; ++et) { u32x2 sw; sw.x = pk2(S[et][0], S[et][1]); sw.y = pk2(S[et][2], S[et][3]);
                *(LAS u32x2*)(S0T + (16 * et + c) * SD + (16 * w + 4 * q4) * 2) = sw; }
        }
        const long sINC = dir ? -(long)INC : (long)INC;
        bf16_t qn[8], zn[8]; u32x4 vn;
        { const long r0 = (long)(rowof(ch0 * C + 8 * g) * INC);
#pragma unroll
          for (int j = 0; j < 8; ++j) { if (MODE == 1) qn[j] = pq[r0 + j * sINC]; zn[j] = pz[r0 + j * sINC]; } }
        vn = *(const u32x4*)(pv + rowof(ch0 * C + vs) * INC);
        for (int ch = ch0; ch < ch0 + SEGCH; ++ch) {
            bf16_t qc[8], zc[8]; u32x4 vc = vn;
#pragma unroll
            for (int j = 0; j < 8; ++j) { if (MODE == 1) qc[j] = qn[j]; zc[j] = zn[j]; }
            if (ch + 1 < ch0 + SEGCH) { const long r0 = (long)(rowof((ch + 1) * C + 8 * g) * INC);
#pragma unroll
                for (int j = 0; j < 8; ++j) { if (MODE == 1) qn[j] = pq[r0 + j * sINC]; zn[j] = pz[r0 + j * sINC]; }
                vn = *(const u32x4*)(pv + rowof((ch + 1) * C + vs) * INC);
            }
            float qv[8], kk[8], cl[8]; float run = 0.f;
#pragma unroll
            for (int j = 0; j < 8; ++j) { float z = bf2f(zc[j]); z = fminf(fmaxf(z, -75.f), 75.f);
                const float ez = __expf(-z), sg = frcp(1.f + ez), f = lb + oml * sg;
                run += __log2f(f); cl[j] = run; kk[j] = oml * ez * sg; qv[j] = (MODE == 1) ? bf2f(qc[j]) : 0.f; }
            TG[g * 128 + d] = run;
            __syncthreads();
            {
                const float T0a = TG[d], T0b = TG[128 + d], T1a = TG[256 + d], T1b = TG[384 + d];
                const float T0 = T0a + T0b, T1 = T1a + T1b, eT0 = fexp2(T0), eT1 = fexp2(T1);
                const float off = hf ? (sub ? T1a : T0a) : 0.f;
                float ksv[8];
#pragma unroll
                for (int j = 0; j < 8; ++j) { const int t = 8 * g + j;
                    const float cc = fmaxf(off + cl[j], -108.f), e1 = fexp2(cc), r1 = frcp(e1);
                    const float qb = qv[j] * e1, kd = kk[j] * r1;
                    if (MODE == 1) { *(LAS bf16_t*)(QB + t * SD + d * 2) = f2bf(qb); *(LAS bf16_t*)(KD + t * SD + d * 2) = f2bf(kd); }
                    if (sub == 0) { if (MODE == 1) *(LAS bf16_t*)(KE0 + t * SD + d * 2) = f2bf(kd * eT0); ksv[j] = kd * eT0 * eT1; }
                    else { if (MODE == 1) *(LAS bf16_t*)(QC1 + (t - 16) * SD + d * 2) = f2bf(qb * eT0); ksv[j] = kd * eT1; } }
                Ltot += T0 + T1;
                u32x4 kw; kw.x = pk2(ksv[0], ksv[1]); kw.y = pk2(ksv[2], ksv[3]); kw.z = pk2(ksv[4], ksv[5]); kw.w = pk2(ksv[6], ksv[7]);
                *(LAS u32x4*)(KST + d * SS + (8 * g) * 2) = kw;
                if (g == 0) DEC[d] = eT0 * eT1;
#pragma unroll
                for (int k = 0; k < 4; ++k) { *(LAS bf16_t*)(VT + (veg * 8 + 2 * k) * SS + vs * 2) = (bf16_t)(vc[k] & 0xffffu); *(LAS bf16_t*)(VT + (veg * 8 + 2 * k + 1) * SS + vs * 2) = (bf16_t)(vc[k] >> 16); }
            }
            __syncthreads();
            f32x4 o0 = (f32x4){0.f, 0.f, 0.f, 0.f}, o1 = o0;
            if (MODE == 1) {
#pragma unroll
            for (int kq = 0; kq < 4; ++kq) { const int ko = (32 * kq + 8 * q4) * 2;
                const bf16x8 av = *(const LAS bf16x8*)(S0T + (16 * w + c) * SD + ko), b0 = *(const LAS bf16x8*)(QB + c * SD + ko), b1 = *(const LAS bf16x8*)(QC1 + c * SD + ko);
                o0 = __builtin_amdgcn_mfma_f32_16x16x32_bf16(av, b0, o0, 0, 0, 0); o1 = __builtin_amdgcn_mfma_f32_16x16x32_bf16(av, b1, o1, 0, 0, 0); }
            if (w < 3) {
                LAS unsigned char* KM = (w == 1) ? KE0 : (w == 0 ? KD : KD + 16 * SD);
                LAS unsigned char* QM = (w == 0) ? QB : QB + 16 * SD;
                f32x4 at = (f32x4){0.f, 0.f, 0.f, 0.f};
#pragma unroll
                for (int kq = 0; kq < 4; ++kq) { const int ko = (32 * kq + 8 * q4) * 2;
                    const bf16x8 av = *(const LAS bf16x8*)(KM + c * SD + ko), bv = *(const LAS bf16x8*)(QM + c * SD + ko);
                    at = __builtin_amdgcn_mfma_f32_16x16x32_bf16(av, bv, at, 0, 0, 0); }
                if (w != 1) {
#pragma unroll
                    for (int r = 0; r < 4; ++r) if (4 * q4 + r > c) at[r] = 0.f;
                }
                const int t0 = (w == 0) ? 0 : 16, s0 = (w == 2) ? 16 : 0;
                u32x2 pw; pw.x = pk2(at[0], at[1]); pw.y = pk2(at[2], at[3]);
                *(LAS u32x2*)(ATT + (t0 + c) * SS + (s0 + 4 * q4) * 2) = pw;
            } else if (w == 3) {
                *(LAS u32x2*)(ATT + c * SS + (16 + 4 * q4) * 2) = (u32x2){0u, 0u};
            }
            __syncthreads();
            }
            if (MODE == 1) {
                const bf16x8 av = *(const LAS bf16x8*)(VT + (16 * w + c) * SS + 8 * q4 * 2);
                const bf16x8 b0 = *(const LAS bf16x8*)(ATT + c * SS + 8 * q4 * 2), b1 = *(const LAS bf16x8*)(ATT + (16 + c) * SS + 8 * q4 * 2);
                o0 = __builtin_amdgcn_mfma_f32_16x16x32_bf16(av, b0, o0, 0, 0, 0); o1 = __builtin_amdgcn_mfma_f32_16x16x32_bf16(av, b1, o1, 0, 0, 0);
                u32x2 w0, w1; w0.x = pk2(o0[0], o0[1]); w0.y = pk2(o0[2], o0[3]); w1.x = pk2(o1[0], o1[1]); w1.y = pk2(o1[2], o1[3]);
                { bf16_t* op = O + rowof(ch * C + c) * HW + 16 * w + 4 * q4; const long s16 = dir ? -16L * HW : 16L * HW;
                  *(u32x2*)op = w0; *(u32x2*)(op + s16) = w1; }
            }
            {
                const bf16x8 ak = *(const LAS bf16x8*)(KST + (16 * w + c) * SS + 8 * q4 * 2);
                const f32x4 dc = *(const LAS f32x4*)(DEC + 16 * w + 4 * q4);
#pragma unroll
                for (int et = 0; et < 8; ++et) { const bf16x8 bv = *(const LAS bf16x8*)(VT + (16 * et + c) * SS + 8 * q4 * 2);
                    S[et] = __builtin_amdgcn_mfma_f32_16x16x32_bf16(ak, bv, S[et] * dc, 0, 0, 0);
                    if (MODE == 1) { u32x2 sw; sw.x = pk2(S[et][0], S[et][1]); sw.y = pk2(S[et][2], S[et][3]);
                        *(LAS u32x2*)(S0T + (16 * et + c) * SD + (16 * w + 4 * q4) * 2) = sw; } }
            }
        }
        if (MODE == 0) {
            f32x4* uo = (f32x4*)(segU + ((size_t)(seq * (NSEG - 1) + sg) * NTHREADS + tid) * 32);
#pragma unroll
            for (int et = 0; et < 8; ++et) uo[et] = S[et];
            if (g == 0) segD[(size_t)(seq * (NSEG - 1) + sg) * 128 + d] = fexp2(Ltot);
        }
        __syncthreads();
    }
}

__device__ __forceinline__ void scan_summary(const bf16_t* proj, const float* lower_bounds, int l, LAS unsigned char* lds, float* segU, float* segD) {
    constexpr int C = 64, SS = 144, NCHS = SEGCH / 2;
    LAS unsigned char* KST = lds;
    LAS unsigned char* VT = KST + 128 * SS;
    LAS float* TG = (LAS float*)(VT + 128 * SS);
    LAS float* DEC = TG + 512;
    const int tid = otid(), lane = tid & 63, w = __builtin_amdgcn_readfirstlane(tid >> 6), q4 = lane >> 4, c = lane & 15;
    const int d = tid & 127, g = tid >> 7;
    for (int item = blockIdx.x; item < 64 * (NSEG - 1); item += gridDim.x) {
        const int seq = item / (NSEG - 1), sg = item - seq * (NSEG - 1), b = seq >> 3, h = (seq >> 1) & 3, dir = seq & 1, t0 = sg * SEGCH * 32;
        float lb = 0.f;
        if (l > 0) { const float a0 = lower_bounds[(dir * 2 + 0) * HW + h * 128 + d], a1 = lower_bounds[(dir * 2 + 1) * HW + h * 128 + d]; lb = 1.f / (1.f + __expf(a0 - a1)); }
        const float oml = 1.f - lb;
        const bf16_t* pz = proj + (dir ? PC_ZB : PC_ZF) + h * 128 + d;
        const bf16_t* pv = proj + PC_I + h * 128;
        auto rowof = [&](int tt) -> size_t {
            if (tt < CTX) { const int idx = dir ? CTX - 1 - tt : tt; return (size_t)NLAT + b * CTX + idx; }
            const int li = tt - CTX, idx = dir ? SEQ - 1 - li : li; return (size_t)b * SEQ + idx; };
        f32x4 S[8];
#pragma unroll
        for (int i = 0; i < 8; ++i) S[i] = (f32x4){0.f, 0.f, 0.f, 0.f};
        float Ltot = 0.f;
        const long sINC = dir ? -(long)INC : (long)INC;
        bf16_t zn[16]; u32x4 vn[2];
        { const long r0 = (long)(rowof(t0 + 16 * g) * INC);
#pragma unroll
          for (int j = 0; j < 16; ++j) zn[j] = pz[r0 + j * sINC]; }
#pragma unroll
        for (int i = 0; i < 2; ++i) { const int idx = tid + NTHREADS * i; vn[i] = *(const u32x4*)(pv + rowof(t0 + (idx & 63)) * INC + (idx >> 6) * 8); }
        for (int ch = 0; ch < NCHS; ++ch) {
            bf16_t zc[16]; u32x4 vc[2] = {vn[0], vn[1]};
#pragma unroll
            for (int j = 0; j < 16; ++j) zc[j] = zn[j];
            if (ch + 1 < NCHS) { const int tn = t0 + (ch + 1) * C; const long r0 = (long)(rowof(tn + 16 * g) * INC);
#pragma unroll
                for (int j = 0; j < 16; ++j) zn[j] = pz[r0 + j * sINC];
#pragma unroll
                for (int i = 0; i < 2; ++i) { const int idx = tid + NTHREADS * i; vn[i] = *(const u32x4*)(pv + rowof(tn + (idx & 63)) * INC + (idx >> 6) * 8); } }
            float kk[16], cl[16]; float run = 0.f;
#pragma unroll
            for (int j = 0; j < 16; ++j) { float z = bf2f(zc[j]); z = fminf(fmaxf(z, -75.f), 75.f);
                const float ez = __expf(-z), sg2 = frcp(1.f + ez), f = lb + oml * sg2;
                run += __log2f(f); cl[j] = run; kk[j] = oml * ez * sg2; }
            TG[g * 128 + d] = run;
            __syncthreads();
            {
                const float T0 = TG[d], T1 = TG[128 + d], T2 = TG[256 + d], T3 = TG[384 + d];
                const float T = (T0 + T1) + (T2 + T3);
                const float off = (g > 0 ? T0 : 0.f) + (g > 1 ? T1 : 0.f) + (g > 2 ? T2 : 0.f);
                float ks[16];
#pragma unroll
                for (int j = 0; j < 16; ++j) ks[j] = kk[j] * fexp2(T - (off + cl[j]));
                u32x4 k0, k1; k0.x = pk2(ks[0], ks[1]); k0.y = pk2(ks[2], ks[3]); k0.z = pk2(ks[4], ks[5]); k0.w = pk2(ks[6], ks[7]);
                k1.x = pk2(ks[8], ks[9]); k1.y = pk2(ks[10], ks[11]); k1.z = pk2(ks[12], ks[13]); k1.w = pk2(ks[14], ks[15]);
                *(LAS u32x4*)(KST + d * SS + (16 * g) * 2) = k0; *(LAS u32x4*)(KST + d * SS + (16 * g + 8) * 2) = k1;
                if (g == 0) DEC[d] = fexp2(T);
                Ltot += T;
#pragma unroll
                for (int i = 0; i < 2; ++i) { const int idx = tid + NTHREADS * i, vs = idx & 63, veg = idx >> 6;
#pragma unroll
                    for (int k = 0; k < 4; ++k) { *(LAS bf16_t*)(VT + (veg * 8 + 2 * k) * SS + vs * 2) = (bf16_t)(vc[i][k] & 0xffffu); *(LAS bf16_t*)(VT + (veg * 8 + 2 * k + 1) * SS + vs * 2) = (bf16_t)(vc[i][k] >> 16); } }
            }
            __syncthreads();
            {
                const bf16x8 ak0 = *(const LAS bf16x8*)(KST + (16 * w + c) * SS + 8 * q4 * 2), ak1 = *(const LAS bf16x8*)(KST + (16 * w + c) * SS + (32 + 8 * q4) * 2);
                const f32x4 dc = *(const LAS f32x4*)(DEC + 16 * w + 4 * q4);
#pragma unroll
                for (int et = 0; et < 8; ++et) { const bf16x8 b0 = *(const LAS bf16x8*)(VT + (16 * et + c) * SS + 8 * q4 * 2), b1 = *(const LAS bf16x8*)(VT + (16 * et + c) * SS + (32 + 8 * q4) * 2);
                    S[et] = __builtin_amdgcn_mfma_f32_16x16x32_bf16(ak0, b0, S[et] * dc, 0, 0, 0);
                    S[et] = __builtin_amdgcn_mfma_f32_16x16x32_bf16(ak1, b1, S[et], 0, 0, 0); }
            }
        }
        f32x4* uo = (f32x4*)(segU + ((size_t)(seq * (NSEG - 1) + sg) * NTHREADS + tid) * 32);
#pragma unroll
        for (int et = 0; et < 8; ++et) uo[et] = S[et];
        if (g == 0) segD[(size_t)(seq * (NSEG - 1) + sg) * 128 + d] = fexp2(Ltot);
        __syncthreads();
    }
}

__device__ __forceinline__ void pool_phase(bf16_t* proj, bool do_ctx, LAS unsigned char* lds) {
    const int tid = otid(), c = tid, g = c >> 7, hw = 1 << g;
    {
        const int lane = tid & 63, gw = blockIdx.x * NWAVES + (tid >> 6), NGW = gridDim.x * NWAVES;
        for (int wi = gw; wi < NB * 4 * 8 * 16; wi += NGW) {
            const int k2 = wi >> 11, idx = wi & 2047, chunk = idx & 15, strip = (idx >> 4) & 7, gq = (idx >> 7) & 3, gg = k2 ? 3 - gq : gq, b = (idx >> 9) + 4 * k2, hh = 1 << gg, r0 = strip * 16;
            bf16_t* base = proj + ((size_t)b * SEQ + lane) * INC + gg * 128 + chunk * 8;
            float V[8];
#pragma unroll
            for (int k = 0; k < 8; ++k) V[k] = 0.f;
            const u32x4 zero4 = (u32x4){0u, 0u, 0u, 0u};
            auto ldrow = [&](int r) -> u32x4 { return (r >= 0 && r < 128) ? *(const u32x4*)(base + (size_t)r * 64 * INC + PC_PV) : zero4; };
            auto acc8 = [&](const u32x4& x, float sgn) {
#pragma unroll
                for (int k = 0; k < 4; ++k) { V[2 * k] += sgn * bflo(x[k]); V[2 * k + 1] += sgn * bfhi(x[k]); } };
            for (int i0 = 0; i0 < 2 * hh - 1; i0 += 4) { u32x4 t[4];
#pragma unroll
                for (int i = 0; i < 4; ++i) t[i] = (i0 + i < 2 * hh - 1) ? ldrow(r0 - hh + i0 + i) : zero4;
#pragma unroll
                for (int i = 0; i < 4; ++i) acc8(t[i], 1.f); }
            const int c_lo = lane - hh < 0 ? 0 : lane - hh, c_hi = lane + hh > 64 ? 64 : lane + hh;
            u32x4 nnew = ldrow(r0 + hh - 1), nctr = ldrow(r0), nold = ldrow(r0 - hh);
            for (int r = r0; r < r0 + 16; ++r) {
                const u32x4 xnew = nnew, xc = nctr, xold = nold;
                if (r + 1 < r0 + 16) { nnew = ldrow(r + hh); nctr = ldrow(r + 1); nold = ldrow(r + 1 - hh); }
                acc8(xnew, 1.f);
                const int r_lo = r - hh < 0 ? 0 : r - hh, r_hi = r + hh > 128 ? 128 : r + hh;
                const float inv = frcp((float)((r_hi - r_lo) * (c_hi - c_lo)));
                float o[8], F[8], Gs[8];
#pragma unroll
                for (int k = 0; k < 8; ++k) { F[k] = V[k]; Gs[k] = V[k]; }
                for (int dl = 1; dl < hh; dl <<= 1) { const bool fok = lane + dl < 64, gok = lane - dl >= 0;
#pragma unroll
                    for (int k = 0; k < 8; ++k) { const float fd = __shfl_down(F[k], dl), gu = __shfl_up(Gs[k], dl); F[k] += fok ? fd : 0.f; Gs[k] += gok ? gu : 0.f; } }
#pragma unroll
                for (int k = 0; k < 8; ++k) {
                    const float gp = __shfl_up(Gs[k], 1);
                    const float box = F[k] + (lane >= 1 ? gp : 0.f);
                    const float seg = (k & 1) ? bfhi(xc[k >> 1]) : bflo(xc[k >> 1]);
                    o[k] = box * inv - seg; }
                u32x4 w; w.x = pk2(o[0], o[1]); w.y = pk2(o[2], o[3]); w.z = pk2(o[4], o[5]); w.w = pk2(o[6], o[7]);
                *(u32x4*)(base + (size_t)r * 64 * INC + PC_D) = w;
                acc8(xold, -1.f);
            }
        }
    }
    if (do_ctx) {
        for (int item = blockIdx.x; item < NB * (CTX / 64); item += gridDim.x) {
            const int b = item >> 2, t0 = (item & 3) * 64;
            for (int t = 0; t < 64; ++t) { const int tok = t0 + t, lo = tok - hw < 0 ? 0 : tok - hw, hi = tok + hw > CTX ? CTX : tok + hw;
                bf16_t* base = proj + ((size_t)NLAT + b * CTX) * INC; float s = 0.f;
                for (int tt = lo; tt < hi; ++tt) s += bf2f(base[(size_t)tt * INC + PC_PV + c]);
                base[(size_t)tok * INC + PC_D + c] = f2bf(s / (float)(hi - lo) - bf2f(base[(size_t)tok * INC + PC_PV + c])); }
        }
    }
}

__global__ void __launch_bounds__(NTHREADS, 2) mega(Args a) {
    extern __shared__ __attribute__((aligned(16))) unsigned char lds_raw[];
    LAS unsigned char* lds = (LAS unsigned char*)lds_raw;
    cg::grid_group grid = cg::this_grid();
    const int G = gridDim.x, bx = blockIdx.x;
    int ph = 0; const int lo = a.lo, hi = a.hi;
    volatile LAS unsigned* stw = (volatile LAS unsigned*)(lds + LDS_MAIN);
    if (threadIdx.x < 4) stw[threadIdx.x] = 0u;
    __syncthreads();
    const XcdBarrier xbar = xcd_barrier_post((unsigned*)(KWS + OFF_BAR), stw);
#define PH_BEGIN if (ph >= lo && ph < hi) {
#define PH_END } if (ph >= lo && ph + 1 < hi) { if (lo > hi) grid.sync(); else xcd_barrier(xbar); } ++ph;
#define W_U ((bf16_t*)(KWS + OFF_U))
#define W_OF W_U
#define W_OB (W_U + (size_t)MROWS * HW)
#define W_PROJ ((bf16_t*)(KWS + OFF_PROJ))
#define W_ACT W_PROJ
#define W_MERGED (W_PROJ + 1024)
#define W_HC ((bf16_t*)(KWS + OFF_HC) + D)
#define W_HLAT ((bf16_t*)KOUT + D)
#define W_MODL ((const float*)(KWS + OFF_MOD) + (size_t)l * 9 * MODW)
#define W_RSS(j) ((float*)(KWS + OFF_RSS) + (size_t)(l * 3 + (j)) * MROWS)
#define W_NWSC(j) ((const float*)(KWS + OFF_NWSC) + (size_t)(l * 3 + (j)) * 9 * D)
#define W_BIAS(j) ((const float*)(KWS + OFF_BIAS) + (size_t)(l * 3 + (j)) * 9 * NBIAS)

    PH_BEGIN prologue_a(lds); PH_END
    PH_BEGIN prologue_b(); PH_END
    PH_BEGIN { const int l = 0; norm0_phase(KIN(I_X), KIN(I_CTX), W_NWSC(0), W_U, W_RSS(0), MROWS); bias_phase(KWS); } PH_END

    for (int l = 0; l < 2; ++l) {
        const bool last = (l == 1);
        const int nrows = last ? NLAT : MROWS;
        PH_BEGIN { pg8::Gemm g{(const char*)W_U, (const char*)(KWS + OFF_WUP + (size_t)(l * 2) * SZ_WUP), 0, 0, D, D};
            pg8::Sched<1> S; S.init(MROWS, 2 * DFF, G, bx); pg8::EpiUp E{W_ACT, W_RSS(0), W_BIAS(0)}; pg8::gemm_phase(lds, g, S, E); } PH_END
        PH_BEGIN { pg8::Gemm g{(const char*)W_ACT, (const char*)(KWS + OFF_WDN + (size_t)(l * 2) * SZ_WDN), 0, 0, DFF, DFF};
            bf16_t* h_lat = W_HLAT; bf16_t* h_ctx = W_HC; const long dctx = (char*)h_ctx - (char*)h_lat;
            pg8::Sched<1> S; S.init(MROWS, D, G, bx, 1);
            if (l == 0) { const float* xl = KIN(I_X); pg8::EpiRes<true, true> E{xl, (const char*)KIN(I_CTX) - (const char*)xl, h_lat, dctx, W_MODL + 2 * D, W_U, W_NWSC(1), W_RSS(1)}; pg8::gemm_phase(lds, g, S, E); }
            else { pg8::EpiRes<true, false> E{h_lat, dctx, h_lat, dctx, W_MODL + 2 * D, W_U, W_NWSC(1), W_RSS(1)}; pg8::gemm_phase(lds, g, S, E); } } PH_END
        PH_BEGIN { pg8::Gemm g{(const char*)W_U, (const char*)(KWS + OFF_WIN + (size_t)l * SZ_WIN), 0, 0, D, D};
            pg8::Sched<1> S; S.init(MROWS, INC, G, bx); pg8::EpiProj E{W_PROJ, INC, W_RSS(1), W_BIAS(1)}; pg8::gemm_phase(lds, g, S, E); } PH_END
        PH_BEGIN { unsigned char* ws = KWS; scan_summary(W_PROJ, KIN(I_LB), l, lds, (float*)(ws + OFF_SEGU), (float*)(ws + OFF_SEGD)); } PH_END
        PH_BEGIN { unsigned char* ws = KWS; scan_phase<1>(W_PROJ, W_OF, W_OB, KIN(I_LB), l, lds, (float*)(ws + OFF_SEGU), (float*)(ws + OFF_SEGD)); } PH_END
        PH_BEGIN a_phase(W_PROJ, W_OF, W_OB, KIN(I_HGW) + l * HW, nrows); pool_phase(W_PROJ, !last, lds); PH_END
        PH_BEGIN { pg8::Gemm g{(const char*)(W_PROJ + PC_A), (const char*)(KWS + OFF_WA + (size_t)l * SZ_WA), ((long)PC_D - (long)PC_A) * 2, (long)OFF_WE - (long)OFF_WA, INC, HW};
            pg8::Sched<2> S; S.init(nrows, D, G, bx); pg8::EpiMerge E{W_PROJ, W_MERGED, INC}; pg8::gemm_phase(lds, g, S, E); } PH_END
        PH_BEGIN { pg8::Gemm g{(const char*)W_MERGED, (const char*)(KWS + OFF_WOUT + (size_t)l * SZ_WOUT), 0, 0, INC, D};
            bf16_t* h_lat = W_HLAT; bf16_t* h_ctx = W_HC; const long dctx = (char*)h_ctx - (char*)h_lat;
            pg8::Sched<1> S; S.init(nrows, D, G, bx, 1); pg8::EpiRes<false, false> E{h_lat, dctx, h_lat, dctx, W_MODL + 5 * D, W_U, W_NWSC(2), W_RSS(2)}; pg8::gemm_phase(lds, g, S, E); } PH_END
        PH_BEGIN { pg8::Gemm g{(const char*)W_U, (const char*)(KWS + OFF_WUP + (size_t)(l * 2 + 1) * SZ_WUP), 0, 0, D, D};
            pg8::Sched<1> S; S.init(nrows, 2 * DFF, G, bx); pg8::EpiUp E{W_ACT, W_RSS(2), W_BIAS(2)}; pg8::gemm_phase(lds, g, S, E); } PH_END
        PH_BEGIN { pg8::Gemm g{(const char*)W_ACT, (const char*)(KWS + OFF_WDN + (size_t)(l * 2 + 1) * SZ_WDN), 0, 0, DFF, DFF};
            bf16_t* h_lat = W_HLAT; bf16_t* h_ctx = W_HC; const long dctx = (char*)h_ctx - (char*)h_lat;
            pg8::Sched<1> S; S.init(nrows, D, G, bx, 1);
            if (last) { pg8::EpiRes<true, false, false> E{h_lat, dctx, h_lat, dctx, W_MODL + 8 * D, W_U, W_NWSC(3), W_RSS(3)}; pg8::gemm_phase(lds, g, S, E); }
            else { pg8::EpiRes<true, false> E{h_lat, dctx, h_lat, dctx, W_MODL + 8 * D, W_U, W_NWSC(3), W_RSS(3)}; pg8::gemm_phase(lds, g, S, E); } } PH_END
    }
    PH_BEGIN final_norm_phase(KOUT, KIN(I_FNW), (const float*)(KWS + OFF_RSS) + (size_t)6 * MROWS); PH_END
#undef PH_BEGIN
#undef PH_END
}

extern "C" void kernel_launch(void* const* d_in, const int* in_sizes, int n_in, void* d_out, int out_size, void* d_ws, size_t ws_size, hipStream_t stream) {
    static int grid = 0;
    if (grid == 0) {
        if (n_in != 19 || out_size != NLAT * D || ws_size < WS_END) { fprintf(stderr, "kernel_launch: unexpected shapes (n_in %d out %d ws %zu need %zu)\n", n_in, out_size, ws_size, (size_t)WS_END); grid = -1; return; }
        int dev = 0, cus = 0, per_cu = 0;
        hipGetDevice(&dev); hipDeviceGetAttribute(&cus, hipDeviceAttributeMultiprocessorCount, dev);
        if (hipFuncSetAttribute((const void*)mega, hipFuncAttributeMaxDynamicSharedMemorySize, LDS_BYTES) != hipSuccess) { fprintf(stderr, "kernel_launch: hipFuncSetAttribute failed\n"); grid = -1; return; }
        if (hipOccupancyMaxActiveBlocksPerMultiprocessor(&per_cu, (const void*)mega, NTHREADS, LDS_BYTES) != hipSuccess || per_cu < 1) { fprintf(stderr, "kernel_launch: occupancy query gave %d\n", per_cu); per_cu = 1; }
        (void)hipGetLastError();
        grid = cus * per_cu;
        fprintf(stderr, "kernel_launch: grid %d (cus %d x %d), ws %zu\n", grid, cus, per_cu, ws_size);
    }
    if (grid < 0) return;
    if (hipMemsetAsync((unsigned char*)d_ws + OFF_BAR, 0, SZ_BAR, stream) != hipSuccess) { fprintf(stderr, "kernel_launch: memset of barrier words failed\n"); return; }
    Args a{};
    for (int i = 0; i < 19; ++i) a.in[i] = (const float*)d_in[i];
    a.out = (float*)d_out; a.ws = (unsigned char*)d_ws; a.lo = 0; a.hi = 1000;
    void* args[] = {&a};
    hipError_t e = hipLaunchCooperativeKernel((const void*)mega, dim3(grid), dim3(NTHREADS), args, LDS_BYTES, stream);
    if (e != hipSuccess) fprintf(stderr, "kernel_launch: cooperative launch failed: %s (grid %d)\n", hipGetErrorString(e), grid);
}
```

```cpp
#include <hip/hip_runtime.h>
#include <hip/hip_cooperative_groups.h>
#include <cstdio>
namespace cg = cooperative_groups;

#define LAS __attribute__((address_space(3)))
typedef unsigned short bf16_t;
typedef short bf16x8 __attribute__((ext_vector_type(8)));
typedef float f32x4 __attribute__((ext_vector_type(4)));
typedef unsigned u32x4 __attribute__((ext_vector_type(4)));
typedef unsigned u32x2 __attribute__((ext_vector_type(2)));

constexpr int D = 1024, NB = 8, SEQ = 8192, CTX = 256, NLAT = NB * SEQ, NCTX = NB * CTX, MROWS = NLAT + NCTX;
constexpr int DFF = 2816, INC = 5120, HW = 512, NMOD = 9, MODW = NMOD * D;
constexpr float EPS = 1e-6f;
constexpr int PC_Q = 0, PC_ZF = 512, PC_ZB = 1024, PC_I = 1536, PC_G = 2048, PC_PV = 2560, PC_GA = 3072, PC_GB = 4096;
constexpr int PC_D = 0;
constexpr int PC_A = 512;
constexpr int NTHREADS = 512, NWAVES = 8;
constexpr int LDS_MAIN = 131072, LDS_BYTES = LDS_MAIN + 256;
constexpr int KSPLIT = 16;

constexpr size_t SZ_WUP = (size_t)2 * DFF * D * 2, SZ_WDN = (size_t)D * DFF * 2, SZ_WIN = (size_t)INC * D * 2, SZ_WA = (size_t)D * HW * 2, SZ_WOUT = (size_t)D * D * 2;
constexpr size_t OFF_WUP = 0;
constexpr size_t OFF_WDN = OFF_WUP + 4 * SZ_WUP;
constexpr size_t OFF_WIN = OFF_WDN + 4 * SZ_WDN;
constexpr size_t OFF_WA = OFF_WIN + 2 * SZ_WIN;
constexpr size_t OFF_WE = OFF_WA + 2 * SZ_WA;
constexpr size_t OFF_WOUT = OFF_WE + 2 * SZ_WA;
constexpr size_t OFF_MODP = OFF_WOUT + 2 * SZ_WOUT;
constexpr size_t SZ_MODP = (size_t)KSPLIT * 2 * 9 * MODW * 4;
constexpr size_t OFF_MOD = OFF_MODP + SZ_MODP;
constexpr size_t SZ_MOD = (size_t)2 * 9 * MODW * 4;
constexpr size_t OFF_HC = OFF_MOD + SZ_MOD;
constexpr size_t SZ_HC = (size_t)NCTX * D * 4;
constexpr size_t OFF_U = OFF_HC + SZ_HC;
constexpr size_t SZ_U = (size_t)MROWS * D * 2;
constexpr size_t OFF_PROJ = OFF_U + SZ_U;
constexpr size_t SZ_PROJ = (size_t)MROWS * INC * 2;
constexpr int NSEG = 12, SEGCH = 22;
constexpr size_t OFF_SEGU = OFF_PROJ + SZ_PROJ;
constexpr size_t SZ_SEGU = (size_t)64 * (NSEG - 1) * 16384 * 4;
constexpr size_t OFF_SEGD = OFF_SEGU + SZ_SEGU;
constexpr size_t SZ_SEGD = (size_t)64 * (NSEG - 1) * 128 * 4;
constexpr size_t OFF_BAR = OFF_SEGD + SZ_SEGD;
constexpr size_t SZ_BAR = 16384;
constexpr size_t OFF_RSS = OFF_BAR + SZ_BAR;
constexpr size_t SZ_RSS = (size_t)7 * MROWS * 4;
constexpr size_t OFF_NWSC = OFF_RSS + SZ_RSS;
constexpr size_t SZ_NWSC = (size_t)7 * 9 * D * 4;
constexpr int NBIAS = 2 * DFF;
constexpr size_t OFF_BIAS = OFF_NWSC + SZ_NWSC;
constexpr size_t SZ_BIAS = (size_t)6 * 9 * NBIAS * 4;
constexpr size_t WS_END = OFF_BIAS + SZ_BIAS;
static_assert(WS_END <= ((size_t)1 << 30), "workspace must fit 1 GiB");
static_assert((MROWS / 256) % 8 == 0 && (NLAT / 256) % 8 == 0, "row-tile counts must be multiples of the 8-tile row group");

typedef __bf16 bf16x2_t __attribute__((ext_vector_type(2)));
typedef float f32x2_t __attribute__((ext_vector_type(2)));
__device__ __forceinline__ unsigned pk2(float lo, float hi) { f32x2_t v = {lo, hi}; bf16x2_t r = __builtin_convertvector(v, bf16x2_t); return __builtin_bit_cast(unsigned, r); }
__device__ __forceinline__ bf16_t f2bf(float x) { return (bf16_t)(pk2(x, 0.f) & 0xffffu); }
__device__ __forceinline__ float bf2f(bf16_t b) { return __uint_as_float(((unsigned)b) << 16); }
__device__ __forceinline__ float bflo(unsigned w) { return __uint_as_float(w << 16); }
__device__ __forceinline__ float bfhi(unsigned w) { return __uint_as_float(w & 0xffff0000u); }
__device__ __forceinline__ float fexp2(float x) { return __builtin_amdgcn_exp2f(x); }
__device__ __forceinline__ float frcp(float x) { return __builtin_amdgcn_rcpf(x); }
__device__ __forceinline__ float sigm(float x) { return frcp(1.f + __expf(-x)); }
__device__ __forceinline__ float siluf(float x) { return x * frcp(1.f + __expf(-x)); }
__device__ __forceinline__ float wave_sum(float v) {
#pragma unroll
    for (int o = 1; o < 64; o <<= 1) v += __shfl_xor(v, o);
    return v;
}
#define LDS_WAIT() asm volatile("s_waitcnt lgkmcnt(0)" ::: "memory")
__device__ __forceinline__ int otid() { int t = threadIdx.x; asm volatile("" : "+v"(t)); return t; }

namespace pg8 {
constexpr int BM = 256, BK = 64, HALF = 128, HTB = HALF * BK * 2, STAGE_BYTES = 8 * HTB, NXCD = 8, WGM = 4;
__host__ __device__ __forceinline__ int lds_byte(int r, int c) { const int st = (r >> 4) * 2 + (c >> 5), rr = r & 15, cc = c & 31, ob = rr * 64 + cc * 2; return st * 1024 + (ob ^ (((ob >> 9) & 1) << 5)); }
__host__ __device__ __forceinline__ void stage_rc(int b, int& R, int& C) { const int st = b / 1024, sb = b % 1024, swz = sb ^ (((sb >> 9) & 1) << 5); R = (st >> 1) * 16 + swz / 64; C = (st & 1) * 32 + (swz % 64) / 2; }
__host__ __device__ __forceinline__ int perm32(int rho) { const int n = rho >> 4, i = rho & 15; return 8 * (i >> 2) + 4 * n + (i & 3); }

struct Unit { int pm, pn, sub; };
struct Gemm { const char* A; const char* B; long dA, dB; int lda, K; };

template <int NSUB> struct Sched {
    int nM, nN, nwg, G, c, rev;
    __device__ void init(int M, int N, int G_, int c_, int rev_ = 0) { nM = M / BM; nN = N / BM; nwg = nM * nN; G = G_; c = c_; rev = rev_; }
    __device__ bool next(int i, Unit& u) const {
        const int t = (NSUB == 2) ? (i >> 1) : i; u.sub = (NSUB == 2) ? (i & 1) : 0;
        const long L = (long)t * G + c; if (L >= nwg) return false;
        int wgid = (int)L; { const int q = nwg / NXCD, r = nwg % NXCD, xcd = wgid % NXCD, off = wgid / NXCD; wgid = (xcd < r ? xcd * (q + 1) : r * (q + 1) + (xcd - r) * q) + off; }
        const int nig = WGM * nN, gid = wgid / nig, fm = gid * WGM;
        const int pm = fm + ((wgid % nig) % WGM); u.pm = rev ? nM - 1 - pm : pm; u.pn = (wgid % nig) / WGM; return true;
    }
};

template <class Epi, class SchedT>
__device__ __forceinline__ void gemm_phase(LAS unsigned char* lds, const Gemm g, const SchedT& S, const Epi& E) {
    const int tid = otid(), wid = __builtin_amdgcn_readfirstlane(tid >> 6), lane = tid & 63, wr = wid >> 2, wc = wid & 3, fr = lane & 15, fq = lane >> 4;
    const int K = g.K, nt = K / BK;
    unsigned voffA0, voffA1, voffB0, voffB1;
    { int R, C; stage_rc(tid * 16, R, C); const int Rb = Epi::PERM ? ((R & ~31) + perm32(R & 31)) : R; voffA0 = (unsigned)(R * g.lda + C) * 2u; voffB0 = (unsigned)(Rb * K + C) * 2u; }
    { int R, C; stage_rc(tid * 16 + 8192, R, C); const int Rb = Epi::PERM ? ((R & ~31) + perm32(R & 31)) : R; voffA1 = (unsigned)(R * g.lda + C) * 2u; voffB1 = (unsigned)(Rb * K + C) * 2u; }
    const size_t kstep = (size_t)(BK * 2);
    const size_t hstepA = (size_t)HALF * g.lda * 2, hstepB = (size_t)HALF * K * 2;
    const size_t tstepA = 2 * hstepA, tstepB = 2 * hstepB;
    const unsigned ldsw = (unsigned)wid * 1024u;
    const int aoff = lds_byte(wr * 64 + fr, fq * 8), boff = lds_byte(wc * 32 + fr, fq * 8);
#define PG8_SA(b, h) (((b) * 2 + (h)) * HTB)
#define PG8_SB(b, h) ((4 + (b) * 2 + (h)) * HTB)
#define PG8_STAGE(bufoff, gbase, voff) do { \
        __builtin_amdgcn_global_load_lds((const unsigned*)((const char*)(gbase) + voff##0), (LAS unsigned*)(lds + (bufoff) + ldsw), 16, 0, 0); \
        __builtin_amdgcn_global_load_lds((const unsigned*)((const char*)(gbase) + voff##1), (LAS unsigned*)(lds + (bufoff) + ldsw + 8192), 16, 0, 0); } while (0)
#define PG8_LDA(dst, b, h) do { _Pragma("unroll") for (int m = 0; m < 4; ++m) _Pragma("unroll") for (int k = 0; k < 2; ++k) dst[m][k] = *(const LAS bf16x8*)(lds + PG8_SA(b, h) + aoff + m * 2048 + k * 1024); } while (0)
#define PG8_LDB(dst, b, h) do { _Pragma("unroll") for (int n = 0; n < 2; ++n) _Pragma("unroll") for (int k = 0; k < 2; ++k) dst[n][k] = *(const LAS bf16x8*)(lds + PG8_SB(b, h) + boff + n * 2048 + k * 1024); } while (0)
#define PG8_MMA(ai, bj, At, Bt) do { __builtin_amdgcn_s_setprio(1); _Pragma("unroll") for (int m = 0; m < 4; ++m) _Pragma("unroll") for (int n = 0; n < 2; ++n) _Pragma("unroll") for (int k = 0; k < 2; ++k) \
        acc[ai][bj][m][n] = __builtin_amdgcn_mfma_f32_16x16x32_bf16(Bt[n][k], At[m][k], acc[ai][bj][m][n], 0, 0, 0); __builtin_amdgcn_s_setprio(0); } while (0)
#define PG8_WAIT_V(n) asm volatile("s_waitcnt vmcnt(" #n ")" ::: "memory")
#define PG8_WAIT_L(n) asm volatile("s_waitcnt lgkmcnt(" #n ")" ::: "memory")
#define PG8_BAR __builtin_amdgcn_s_barrier()
#define PG8_SCHED __builtin_amdgcn_sched_barrier(0)
    Unit cur, nxt; int ui = 0;
    if (!S.next(0, cur)) return;
    f32x4 acc[2][2][4][2];
#pragma unroll
    for (int a = 0; a < 2; ++a)
#pragma unroll
        for (int b = 0; b < 2; ++b)
#pragma unroll
            for (int m = 0; m < 4; ++m)
#pragma unroll
                for (int n = 0; n < 2; ++n) acc[a][b][m][n] = (f32x4){0.f, 0.f, 0.f, 0.f};
    bf16x8 At[4][2], B0[2][2], B1[2][2];
    const char* cA = g.A + (long)cur.sub * g.dA + (size_t)cur.pm * tstepA; const char* cB = g.B + (long)cur.sub * g.dB + (size_t)cur.pn * tstepB;
    PG8_STAGE(PG8_SB(0, 0), cB, voffB); PG8_STAGE(PG8_SA(0, 0), cA, voffA); PG8_STAGE(PG8_SB(0, 1), cB + hstepB, voffB); PG8_STAGE(PG8_SA(0, 1), cA + hstepA, voffA);
    if (wr == 1) PG8_BAR;
    PG8_WAIT_V(4); PG8_BAR;
    PG8_STAGE(PG8_SB(1, 0), cB + kstep, voffB); PG8_STAGE(PG8_SA(1, 0), cA + kstep, voffA); PG8_STAGE(PG8_SB(1, 1), cB + hstepB + kstep, voffB);
    PG8_WAIT_V(6); PG8_BAR;
    for (;;) {
        const bool has_next = S.next(ui + 1, nxt);
        const char* nA = has_next ? g.A + (long)nxt.sub * g.dA + (size_t)nxt.pm * tstepA : cA; const char* nB = has_next ? g.B + (long)nxt.sub * g.dB + (size_t)nxt.pn * tstepB : cB;
        for (int t = 0; t < nt; t += 2) {
            const bool last = (t == nt - 2);
            const char* a1 = cA + (size_t)(t + 1) * kstep;
            const char* a2 = last ? nA : cA + (size_t)(t + 2) * kstep; const char* b2 = last ? nB : cB + (size_t)(t + 2) * kstep;
            const char* a3 = a2 + kstep; const char* b3 = b2 + kstep;
            PG8_LDB(B0, 0, 0); PG8_SCHED; PG8_LDA(At, 0, 0); PG8_STAGE(PG8_SA(1, 1), a1 + hstepA, voffA);
            PG8_WAIT_L(8); PG8_BAR; PG8_WAIT_L(0); PG8_MMA(0, 0, At, B0); PG8_BAR; PG8_SCHED;
            PG8_LDB(B1, 0, 1); PG8_STAGE(PG8_SB(0, 0), b2, voffB);
            PG8_BAR; PG8_WAIT_L(0); PG8_MMA(0, 1, At, B1); PG8_BAR;
            PG8_LDA(At, 0, 1); PG8_STAGE(PG8_SA(0, 0), a2, voffA);
            PG8_BAR; PG8_WAIT_L(0); PG8_MMA(1, 0, At, B0); PG8_BAR; PG8_SCHED;
            PG8_STAGE(PG8_SB(0, 1), b2 + hstepB, voffB);
            PG8_WAIT_V(6); PG8_BAR; PG8_MMA(1, 1, At, B1); PG8_BAR;
            PG8_LDB(B0, 1, 0); PG8_SCHED; PG8_LDA(At, 1, 0); PG8_STAGE(PG8_SA(0, 1), a2 + hstepA, voffA);
            PG8_WAIT_L(8); PG8_BAR; PG8_WAIT_L(0); PG8_MMA(0, 0, At, B0); PG8_BAR; PG8_SCHED;
            PG8_LDB(B1, 1, 1); PG8_STAGE(PG8_SB(1, 0), b3, voffB);
            PG8_BAR; PG8_WAIT_L(0); PG8_MMA(0, 1, At, B1); PG8_BAR;
            PG8_LDA(At, 1, 1); PG8_STAGE(PG8_SA(1, 0), a3, voffA);
            PG8_BAR; PG8_WAIT_L(0); PG8_MMA(1, 0, At, B0); PG8_BAR; PG8_SCHED;
            PG8_STAGE(PG8_SB(1, 1), b3 + hstepB, voffB);
            PG8_WAIT_V(6); PG8_BAR; PG8_MMA(1, 1, At, B1); PG8_BAR;
        }
        const bool keep = E(acc, cur, wr, wc, fr, fq);
        if (!has_next) break;
        if (!keep) {
#pragma unroll
            for (int a = 0; a < 2; ++a)
#pragma unroll
                for (int b = 0; b < 2; ++b)
#pragma unroll
                    for (int m = 0; m < 4; ++m)
#pragma unroll
                        for (int n = 0; n < 2; ++n) acc[a][b][m][n] = (f32x4){0.f, 0.f, 0.f, 0.f};
        }
        cur = nxt; cA = nA; cB = nB; ++ui;
    }
    PG8_WAIT_V(0);
    if (wr == 0) PG8_BAR;
    PG8_BAR;
#undef PG8_SA
#undef PG8_SB
#undef PG8_STAGE
#undef PG8_LDA
#undef PG8_LDB
#undef PG8_MMA
#undef PG8_WAIT_V
#undef PG8_WAIT_L
#undef PG8_BAR
#undef PG8_SCHED
}

struct EpiUp {
    static constexpr bool PERM = true;
    bf16_t* act; const float* rss; const float* bias;
    __device__ __forceinline__ bool operator()(f32x4 (&acc)[2][2][4][2], const Unit& u, int wr, int wc, int fr, int fq) const {
        const int row0 = u.pm * BM + wr * 64 + fr, hid0 = u.pn * 128 + wc * 32 + 8 * fq, mi = u.pm < (NLAT / BM) ? (u.pm >> 5) : 8;
        const float* bp = bias + (size_t)mi * NBIAS + u.pn * BM + wc * 32 + 8 * fq;
        const f32x4 bg0 = *(const f32x4*)(bp), bg1 = *(const f32x4*)(bp + 4), bu0 = *(const f32x4*)(bp + HALF), bu1 = *(const f32x4*)(bp + HALF + 4);
        float rs[2][4];
#pragma unroll
        for (int ai = 0; ai < 2; ++ai)
#pragma unroll
            for (int m = 0; m < 4; ++m) rs[ai][m] = rss[row0 + ai * HALF + m * 16];
#pragma unroll
        for (int ai = 0; ai < 2; ++ai)
#pragma unroll
            for (int m = 0; m < 4; ++m) { const int row = row0 + ai * HALF + m * 16; const float rr = rsqrtf(rs[ai][m] * (1.f / D) + EPS);
                const f32x4 g0 = acc[ai][0][m][0] * rr + bg0, g1 = acc[ai][0][m][1] * rr + bg1, u0 = acc[ai][1][m][0] * rr + bu0, u1 = acc[ai][1][m][1] * rr + bu1;
                u32x4 w; w.x = pk2(siluf(g0[0]) * u0[0], siluf(g0[1]) * u0[1]); w.y = pk2(siluf(g0[2]) * u0[2], siluf(g0[3]) * u0[3]);
                w.z = pk2(siluf(g1[0]) * u1[0], siluf(g1[1]) * u1[1]); w.w = pk2(siluf(g1[2]) * u1[2], siluf(g1[3]) * u1[3]);
                *(u32x4*)(act + (size_t)row * DFF + hid0) = w; }
        return false;
    }
};
template <bool CHALF, bool SRCF32, bool WRHS = true> struct EpiRes {
    static constexpr bool PERM = true;
    const void* src_lat; long src_dctx; bf16_t* dst_lat; long dst_dctx; const float* modv; bf16_t* hs; const float* nwsc; float* rss;
    __device__ __forceinline__ bool operator()(f32x4 (&acc)[2][2][4][2], const Unit& u, int wr, int wc, int fr, int fq) const {
        const bool isl = u.pm < (NLAT / BM); const int mi = isl ? (u.pm >> 5) : 8;
        const size_t rbase = (size_t)(isl ? u.pm : u.pm - NLAT / BM) * BM + wr * 64 + fr;
        const int col0 = u.pn * BM + wc * 32 + 8 * fq;
        constexpr int HLD = 2 * D;
        constexpr int SLD = SRCF32 ? D : HLD;
        const char* sp = (const char*)src_lat + (isl ? 0L : src_dctx) + (rbase * SLD + col0) * (SRCF32 ? 4 : 2);
        bf16_t* dp = (bf16_t*)((char*)dst_lat + (isl ? 0L : dst_dctx)) + rbase * HLD + col0;
        bf16_t* hp = hs + ((size_t)u.pm * BM + wr * 64 + fr) * D + col0; float* rp = rss + (size_t)u.pm * BM + wr * 64 + fr;
        const float* mv = modv + (size_t)mi * MODW + col0; const float* np = nwsc + (size_t)mi * D + col0;
        f32x4 gq[2][2], nq[2];
#pragma unroll
        for (int bj = 0; bj < 2; ++bj) { gq[bj][0] = *(const f32x4*)(mv + bj * HALF) * (CHALF ? 0.5f : 1.0f); gq[bj][1] = *(const f32x4*)(mv + bj * HALF + 4) * (CHALF ? 0.5f : 1.0f); }
        nq[0] = *(const f32x4*)(np); nq[1] = *(const f32x4*)(np + 4);
        auto finish = [&](int b, const f32x4 (&d0)[2], const f32x4 (&d1)[2]) { const int bj = b >> 2, ai = (b >> 1) & 1, mh = b & 1;
#pragma unroll
            for (int mm = 0; mm < 2; ++mm) { const int m = 2 * mh + mm; const size_t ro = (size_t)(ai * HALF + m * 16) * D + bj * HALF, rh = (size_t)(ai * HALF + m * 16) * HLD + bj * HALF;
                const f32x4 o0 = d0[mm] + gq[bj][0] * acc[ai][bj][m][0], o1 = d1[mm] + gq[bj][1] * acc[ai][bj][m][1];
                u32x4 w; w.x = pk2(o0[0], o0[1]); w.y = pk2(o0[2], o0[3]); w.z = pk2(o1[0], o1[1]); w.w = pk2(o1[2], o1[3]);
                *(u32x4*)(dp + rh) = w;
                const f32x4 r0 = (f32x4){bflo(w.x), bfhi(w.x), bflo(w.y), bfhi(w.y)}, r1 = (f32x4){bflo(w.z), bfhi(w.z), bflo(w.w), bfhi(w.w)};
                acc[ai][bj][m][0] = r0; acc[ai][bj][m][1] = r1;
                if (WRHS) { const f32x4 h0 = r0 * nq[0], h1 = r1 * nq[1]; u32x4 hw; hw.x = pk2(h0[0], h0[1]); hw.y = pk2(h0[2], h0[3]); hw.z = pk2(h1[0], h1[1]); hw.w = pk2(h1[2], h1[3]);
                    *(u32x4*)(hp + ro) = hw; } } };
        if constexpr (SRCF32) {
#pragma unroll
            for (int b = 0; b < 8; ++b) { const int bj = b >> 2, ai = (b >> 1) & 1, mh = b & 1; f32x4 d0[2], d1[2];
                if (b == 4 && WRHS) { nq[0] = *(const f32x4*)(np + HALF); nq[1] = *(const f32x4*)(np + HALF + 4); }
#pragma unroll
                for (int mm = 0; mm < 2; ++mm) { const size_t ro = (size_t)(ai * HALF + (2 * mh + mm) * 16) * SLD + bj * HALF; d0[mm] = *(const f32x4*)(sp + ro * 4); d1[mm] = *(const f32x4*)(sp + ro * 4 + 16); }
                finish(b, d0, d1); }
        } else {
            u32x4 raw[2][2];
#pragma unroll
            for (int mm = 0; mm < 2; ++mm) raw[0][mm] = *(const u32x4*)(sp + ((size_t)(mm * 16) * SLD) * 2);
#pragma unroll
            for (int b = 0; b < 8; ++b) {
                if (b < 7) { const int bj2 = (b + 1) >> 2, ai2 = ((b + 1) >> 1) & 1, mh2 = (b + 1) & 1;
#pragma unroll
                    for (int mm = 0; mm < 2; ++mm) raw[(b + 1) & 1][mm] = *(const u32x4*)(sp + ((size_t)(ai2 * HALF + (2 * mh2 + mm) * 16) * SLD + bj2 * HALF) * 2); }
                if (b == 4 && WRHS) { nq[0] = *(const f32x4*)(np + HALF); nq[1] = *(const f32x4*)(np + HALF + 4); }
                f32x4 d0[2], d1[2];
#pragma unroll
                for (int mm = 0; mm < 2; ++mm) { const u32x4 w = raw[b & 1][mm]; d0[mm] = (f32x4){bflo(w[0]), bfhi(w[0]), bflo(w[1]), bfhi(w[1])}; d1[mm] = (f32x4){bflo(w[2]), bfhi(w[2]), bflo(w[3]), bfhi(w[3])}; }
                finish(b, d0, d1); }
        }
#pragma unroll
        for (int ai = 0; ai < 2; ++ai)
#pragma unroll
            for (int m = 0; m < 4; ++m) { float v = 0.f;
#pragma unroll
                for (int bj = 0; bj < 2; ++bj)
#pragma unroll
                    for (int n = 0; n < 2; ++n) { const f32x4 o = acc[ai][bj][m][n]; v += (o[0] * o[0] + o[1] * o[1]) + (o[2] * o[2] + o[3] * o[3]); }
                v += __shfl_xor(v, 16); v += __shfl_xor(v, 32);
                if (fq == 0) atomicAdd(rp + ai * HALF + m * 16, v); }
        return false;
    }
};
struct EpiProj {
    static constexpr bool PERM = true;
    bf16_t* O; int ldc; const float* rss; const float* bias;
    __device__ __forceinline__ bool operator()(f32x4 (&acc)[2][2][4][2], const Unit& u, int wr, int wc, int fr, int fq) const {
        const int row0 = u.pm * BM + wr * 64 + fr, col0 = u.pn * BM + wc * 32 + 8 * fq, mi = u.pm < (NLAT / BM) ? (u.pm >> 5) : 8;
        const float* bp = bias + (size_t)mi * NBIAS + col0;
        const bool qsilu = u.pn * BM < PC_ZF;
        float rr[2][4];
#pragma unroll
        for (int ai = 0; ai < 2; ++ai)
#pragma unroll
            for (int m = 0; m < 4; ++m) rr[ai][m] = rsqrtf(rss[row0 + ai * HALF + m * 16] * (1.f / D) + EPS);
#pragma unroll
        for (int bj = 0; bj < 2; ++bj) { const f32x4 b0 = *(const f32x4*)(bp + bj * HALF), b1 = *(const f32x4*)(bp + bj * HALF + 4);
#pragma unroll
            for (int ai = 0; ai < 2; ++ai)
#pragma unroll
                for (int m = 0; m < 4; ++m) { bf16_t* rowp = O + (size_t)(row0 + ai * HALF + m * 16) * ldc + col0;
                    f32x4 v0 = acc[ai][bj][m][0] * rr[ai][m] + b0, v1 = acc[ai][bj][m][1] * rr[ai][m] + b1;
                    if (qsilu) {
#pragma unroll
                        for (int j = 0; j < 4; ++j) { v0[j] = siluf(v0[j]); v1[j] = siluf(v1[j]); } }
                    u32x4 w; w.x = pk2(v0[0], v0[1]); w.y = pk2(v0[2], v0[3]); w.z = pk2(v1[0], v1[1]); w.w = pk2(v1[2], v1[3]);
                    *(u32x4*)(rowp + bj * HALF) = w; } }
        return false;
    }
};
struct EpiMerge {
    static constexpr bool PERM = true;
    const bf16_t* proj; bf16_t* merged; int ldm;
    __device__ __forceinline__ bool operator()(f32x4 (&acc)[2][2][4][2], const Unit& u, int wr, int wc, int fr, int fq) const {
        const int row0 = u.pm * BM + wr * 64 + fr, col0 = u.pn * BM + wc * 32 + 8 * fq;
        if (u.sub == 0) {
#pragma unroll
            for (int ai = 0; ai < 2; ++ai)
#pragma unroll
                for (int bj = 0; bj < 2; ++bj) { u32x4 gaq[4], gbq[4];
#pragma unroll
                    for (int m = 0; m < 4; ++m) { const bf16_t* pr = proj + (size_t)(row0 + ai * HALF + m * 16) * INC + col0 + bj * HALF; gaq[m] = *(const u32x4*)(pr + PC_GA); gbq[m] = *(const u32x4*)(pr + PC_GB); }
#pragma unroll
                    for (int m = 0; m < 4; ++m) { const u32x4 gaw = gaq[m], gbw = gbq[m];
#pragma unroll
                        for (int k = 0; k < 4; ++k) { const int n = k >> 1, j = (k & 1) * 2;
                            acc[ai][bj][m][n][j] *= (1.f + __expf(-bflo(gbw[k]))) * frcp(1.f + __expf(-bflo(gaw[k])));
                            acc[ai][bj][m][n][j + 1] *= (1.f + __expf(-bfhi(gbw[k]))) * frcp(1.f + __expf(-bfhi(gaw[k]))); } } }
            return true;
        }
#pragma unroll
        for (int ai = 0; ai < 2; ++ai) {
            u32x4 gb[4][2];
#pragma unroll
            for (int m = 0; m < 4; ++m)
#pragma unroll
                for (int bj = 0; bj < 2; ++bj) gb[m][bj] = *(const u32x4*)(proj + (size_t)(row0 + ai * HALF + m * 16) * INC + col0 + PC_GB + bj * HALF);
#pragma unroll
            for (int m = 0; m < 4; ++m)
#pragma unroll
                for (int bj = 0; bj < 2; ++bj) { const u32x4 gbw = gb[m][bj]; float o[8];
#pragma unroll
                    for (int k = 0; k < 4; ++k) { const int n = k >> 1, j = (k & 1) * 2;
                        o[2 * k] = acc[ai][bj][m][n][j] * frcp(1.f + __expf(-bflo(gbw[k]))); o[2 * k + 1] = acc[ai][bj][m][n][j + 1] * frcp(1.f + __expf(-bfhi(gbw[k]))); }
                    u32x4 w; w.x = pk2(o[0], o[1]); w.y = pk2(o[2], o[3]); w.z = pk2(o[4], o[5]); w.w = pk2(o[6], o[7]);
                    *(u32x4*)(merged + (size_t)(row0 + ai * HALF + m * 16) * ldm + col0 + bj * HALF) = w; }
        }
        return false;
    }
};
}

#define XB_TMO      128
#define XB_XCNT(j)  (256  + 64 * (j))
#define XB_XSUB(j)  (1280 + 64 * (j))
#define XB_XGEN(j)  (2304 + 64 * (j))
#define XB_TOP      3328
#define XB_TOPGEN   3392
#define XCD_BAR_WORDS 3456
#define XB_SPIN_CAP (1u << 20)
__device__ __forceinline__ unsigned xb_ld(unsigned* p)              { return __hip_atomic_load(p, __ATOMIC_RELAXED, __HIP_MEMORY_SCOPE_AGENT); }
__device__ __forceinline__ unsigned xb_add(unsigned* p, unsigned v) { return __hip_atomic_fetch_add(p, v, __ATOMIC_RELAXED, __HIP_MEMORY_SCOPE_AGENT); }
__device__ __forceinline__ unsigned xb_xcc_id() { return (unsigned)__builtin_amdgcn_s_getreg((3 << 11) | 20) & 0xFu; }
#define XB_SPIN(cond, bar) do { unsigned _sp = 0; while (cond) { __builtin_amdgcn_s_sleep(1); \
    if ((++_sp & 255u) == 0u) { if (xb_ld(&(bar)[XB_TMO])) break; if (_sp > XB_SPIN_CAP) { atomicAdd(&(bar)[XB_TMO], 1u); break; } } } } while (0)
struct XcdBarrier { unsigned* bar; unsigned x; volatile LAS unsigned* st; };
__device__ __forceinline__ XcdBarrier xcd_barrier_post(unsigned* bar, volatile LAS unsigned* st) {
    XcdBarrier b; b.bar = bar; b.x = xb_xcc_id(); b.st = st;
    if (threadIdx.x == 0) (void)xb_add(&bar[XB_XCNT(b.x)], 1u);
    return b;
}
__device__ __forceinline__ void xcd_barrier_complete(unsigned* bar, unsigned x, unsigned& nloc, unsigned& nx) {
    const unsigned G = gridDim.x * gridDim.y * gridDim.z;
    unsigned sum, cnt, mine, sp = 0u;
    for (;;) {
        sum = 0u; cnt = 0u; mine = 0u;
#pragma unroll
        for (unsigned j = 0; j < 16; ++j) { const unsigned c = xb_ld(&bar[XB_XCNT(j)]); sum += c; cnt += (c > 0u) ? 1u : 0u; mine = (j == x) ? c : mine; }
        if (sum == G) break;
        __builtin_amdgcn_s_sleep(1);
        if ((++sp & 255u) == 0u) { if (xb_ld(&bar[XB_TMO])) break; if (sp > XB_SPIN_CAP) { atomicAdd(&bar[XB_TMO], 1u); break; } }
    }
    nloc = mine > 0u ? mine : 1u; nx = cnt > 0u ? cnt : 1u;
}
__device__ __forceinline__ void xcd_barrier(const XcdBarrier& b) {
    asm volatile("s_waitcnt vmcnt(0)" ::: "memory");
    __syncthreads();
    if (threadIdx.x == 0) {
        unsigned* bar = b.bar;
        __builtin_amdgcn_s_waitcnt(0);
        unsigned nloc = b.st[0], nx = b.st[1];
        if (nloc == 0u) { xcd_barrier_complete(bar, b.x, nloc, nx); b.st[0] = nloc; b.st[1] = nx; }
        const unsigned old = xb_add(&bar[XB_XSUB(b.x)], 1u);
        const unsigned gen = old / nloc;
        if (old + 1u == (gen + 1u) * nloc) {
            __builtin_amdgcn_fence(__ATOMIC_RELEASE, "agent");
            asm volatile("s_waitcnt vmcnt(0)" ::: "memory");
            const unsigned og = xb_add(&bar[XB_TOP], 1u);
            const unsigned tg = og / nx;
            if (og + 1u == (tg + 1u) * nx) xb_add(&bar[XB_TOPGEN], 1u);
            else XB_SPIN(xb_ld(&bar[XB_TOPGEN]) == tg, bar);
            __builtin_amdgcn_fence(__ATOMIC_ACQUIRE, "agent");
            xb_add(&bar[XB_XGEN(b.x)], 1u);
            asm volatile("s_waitcnt vmcnt(0)" ::: "memory");
        } else {
            XB_SPIN(xb_ld(&bar[XB_XGEN(b.x)]) == gen, bar);
            __builtin_amdgcn_fence(__ATOMIC_ACQUIRE, "agent");
            asm volatile("s_waitcnt vmcnt(0)" ::: "memory");
        }
    }
    __syncthreads();
}

struct Args { const float* in[19]; float* out; unsigned char* ws; int lo, hi; };
typedef const __attribute__((address_space(4))) char* kptr_t;
__device__ __forceinline__ kptr_t kargs() { kptr_t p = (kptr_t)__builtin_amdgcn_kernarg_segment_ptr(); asm volatile("" : "+s"(p)); return p; }
#define KIN(i) (*(const float* const __attribute__((address_space(4)))*)(kargs() + 8 * (i)))
#define KOUT (*(float* const __attribute__((address_space(4)))*)(kargs() + 8 * 19))
#define KWS (*(unsigned char* const __attribute__((address_space(4)))*)(kargs() + 8 * 20))
enum { I_X = 0, I_C, I_CTX, I_CCTX, I_ADAW, I_ADAB, I_NORMW, I_WG, I_WU, I_WD, I_WIN, I_LB, I_HGW, I_POOLW, I_POOLS, I_WBA, I_WBB, I_WOUT, I_FNW };

template <class RowMap>
__device__ __forceinline__ void transpose_item(const float* src0, size_t ld, int K, bf16_t* WT, int k0, const RowMap& rm, LAS float* scr, int lane) {
    const float* src = src0 + (lane & 31) + (size_t)(k0 + (lane >> 5)) * ld;
    float tv[32];
#pragma unroll
    for (int i = 0; i < 32; ++i) tv[i] = src[(size_t)(2 * i) * ld];
#pragma unroll
    for (int i = 0; i < 32; ++i) scr[(2 * i + (lane >> 5)) * 33 + (lane & 31)] = tv[i];
    LDS_WAIT();
    const int c = lane & 7;
#pragma unroll
    for (int j = 0; j < 4; ++j) { const int n = (lane >> 3) + 8 * j; const LAS float* s = scr + (8 * c) * 33 + n;
        u32x4 o; o.x = pk2(s[0 * 33], s[1 * 33]); o.y = pk2(s[2 * 33], s[3 * 33]); o.z = pk2(s[4 * 33], s[5 * 33]); o.w = pk2(s[6 * 33], s[7 * 33]);
        *(u32x4*)(WT + (size_t)rm(n) * K + k0 + 8 * c) = o; }
    LDS_WAIT();
}
struct RowPlain { int n0; __device__ __forceinline__ int operator()(int i) const { return n0 + i; } };


__device__ __forceinline__ void prologue_a(LAS unsigned char* lds) {
    const int tid = otid(), lane = tid & 63, wave = tid >> 6, G = gridDim.x;
    unsigned char* ws = KWS;
    LAS float* scr = (LAS float*)(lds + wave * 8704);
    constexpr int IT_UP = (D / 64) * (2 * DFF / 32), IT_DN = (DFF / 64) * (D / 32), IT_IN = (D / 64) * (INC / 32), IT_A = (HW / 64) * (D / 32), IT_OUT = (D / 64) * (D / 32);
    constexpr int IT_LAYER = 2 * IT_UP + 2 * IT_DN + IT_IN + IT_A + IT_OUT;
    for (int it = blockIdx.x * NWAVES + wave; it < 2 * IT_LAYER; it += G * NWAVES) {
        const int l = it / IT_LAYER; int r = it % IT_LAYER;
        if (r < 2 * IT_UP) { const int hh = r / IT_UP; r %= IT_UP; const size_t wo = ((size_t)(l * 2 + hh)) * D * DFF;
            constexpr int nblk = 2 * DFF / 32; const int kb = r / nblk, nb = r % nblk, n0 = 32 * nb, tile = n0 >> 8, cl = n0 & 255, sel = cl >> 7, hcol = 128 * tile + (cl & 127);
            const float* wsrc = (const float*)(sel ? (unsigned long long)KIN(I_WU) : (unsigned long long)KIN(I_WG));
            RowPlain rm{n0}; transpose_item(wsrc + wo + hcol, DFF, D, (bf16_t*)(ws + OFF_WUP + (size_t)(l * 2 + hh) * SZ_WUP), 64 * kb, rm, scr, lane); continue; }
        r -= 2 * IT_UP;
        if (r < 2 * IT_DN) { const int hh = r / IT_DN; r %= IT_DN; constexpr int nblk = D / 32; const int kb = r / nblk, nb = r % nblk;
            RowPlain rm{32 * nb}; transpose_item(KIN(I_WD) + ((size_t)(l * 2 + hh)) * DFF * D + 32 * nb, D, DFF, (bf16_t*)(ws + OFF_WDN + (size_t)(l * 2 + hh) * SZ_WDN), 64 * kb, rm, scr, lane); continue; }
        r -= 2 * IT_DN;
        if (r < IT_IN) { constexpr int nblk = INC / 32; const int kb = r / nblk, nb = r % nblk;
            RowPlain rm{32 * nb}; transpose_item(KIN(I_WIN) + (size_t)l * D * INC + 32 * nb, INC, D, (bf16_t*)(ws + OFF_WIN + (size_t)l * SZ_WIN), 64 * kb, rm, scr, lane); continue; }
        r -= IT_IN;
        if (r < IT_A) { constexpr int nblk = D / 32; const int kb = r / nblk, nb = r % nblk;
            RowPlain rm{32 * nb}; transpose_item(KIN(I_WBA) + (size_t)l * HW * D + 32 * nb, D, HW, (bf16_t*)(ws + OFF_WA + (size_t)l * SZ_WA), 64 * kb, rm, scr, lane); continue; }
        r -= IT_A;
        { constexpr int nblk = D / 32; const int kb = r / nblk, nb = r % nblk;
            RowPlain rm{32 * nb}; transpose_item(KIN(I_WOUT) + (size_t)l * D * D + 32 * nb, D, D, (bf16_t*)(ws + OFF_WOUT + (size_t)l * SZ_WOUT), 64 * kb, rm, scr, lane); }
    }
    { float* rz = (float*)(ws + OFF_RSS); for (int i = blockIdx.x * NTHREADS + tid; i < 7 * MROWS; i += G * NTHREADS) rz[i] = 0.f; }
    { float* nz = (float*)(ws + OFF_NWSC) + 6 * 9 * D; for (int i = blockIdx.x * NTHREADS + tid; i < 9 * D; i += G * NTHREADS) nz[i] = 0.f; }
    __syncthreads();
    {
        LAS float* sv = (LAS float*)lds;
        float* modp = (float*)(ws + OFF_MODP);
        constexpr int NCT = MODW / 512;
        for (int it = blockIdx.x; it < 2 * NCT * KSPLIT; it += G) {
            const int l = it / (NCT * KSPLIT), ct = (it / KSPLIT) % NCT, ks = it % KSPLIT;
            for (int idx = tid; idx < 9 * 64; idx += NTHREADS) { const int mi = idx >> 6, k = ks * 64 + (idx & 63); const float cv = mi < 8 ? KIN(I_C)[mi * D + k] : KIN(I_CCTX)[k]; sv[idx] = siluf(cv); }
            __syncthreads();
            const int col = ct * 512 + tid;
            float acc[9];
#pragma unroll
            for (int mi = 0; mi < 9; ++mi) acc[mi] = 0.f;
            const float* w = KIN(I_ADAW) + ((size_t)l * D + ks * 64) * MODW + col;
#pragma unroll 16
            for (int kk = 0; kk < 64; ++kk) { const float wv = w[(size_t)kk * MODW];
#pragma unroll
                for (int mi = 0; mi < 9; ++mi) acc[mi] += sv[mi * 64 + kk] * wv; }
#pragma unroll
            for (int mi = 0; mi < 9; ++mi) modp[((size_t)(ks * 2 + l) * 9 + mi) * MODW + col] = acc[mi];
            __syncthreads();
        }
    }
    {
        LAS float* pvs = (LAS float*)lds;
        for (int it = blockIdx.x; it < 2 * 4 * 2 * 8; it += G) {
            const int cb = it & 7, nh = (it >> 3) & 1, g = (it >> 4) & 3, l = it >> 6, n = nh * 512 + tid, c0 = g * 128 + cb * 16;
            for (int idx = tid; idx < 16 * 128; idx += NTHREADS) { const int cc = idx >> 7, j = idx & 127;
                pvs[idx] = KIN(I_POOLW)[((size_t)(l * 4 + g) * 128 + cb * 16 + cc) * 128 + j] * KIN(I_POOLS)[l * HW + g * 128 + j]; }
            const float* wb = KIN(I_WBB) + ((size_t)l * HW + g * 128) * D + n;
            __syncthreads();
            float sc[16];
#pragma unroll
            for (int cc = 0; cc < 16; ++cc) sc[cc] = 0.f;
#pragma unroll 1
            for (int jq = 0; jq < 4; ++jq) {
                float wv[32];
#pragma unroll
                for (int j = 0; j < 32; ++j) wv[j] = wb[(size_t)(jq * 32 + j) * D];
#pragma unroll
                for (int cc = 0; cc < 16; ++cc) {
#pragma unroll
                    for (int j4 = 0; j4 < 8; ++j4) { const f32x4 p = *(const LAS f32x4*)(pvs + cc * 128 + jq * 32 + 4 * j4);
                        sc[cc] += (p[0] * wv[4 * j4] + p[1] * wv[4 * j4 + 1]) + (p[2] * wv[4 * j4 + 2] + p[3] * wv[4 * j4 + 3]); } } }
            unsigned pk[8];
#pragma unroll
            for (int cp = 0; cp < 8; ++cp) pk[cp] = pk2(sc[2 * cp], sc[2 * cp + 1]);
            bf16_t* we = (bf16_t*)(ws + OFF_WE + (size_t)l * SZ_WA) + (size_t)n * HW + c0;
            *(u32x4*)we = (u32x4){pk[0], pk[1], pk[2], pk[3]}; *(u32x4*)(we + 8) = (u32x4){pk[4], pk[5], pk[6], pk[7]};
            __syncthreads();
        }
    }
}
__device__ __forceinline__ void prologue_b() {
    unsigned char* ws = KWS; const float* modp = (const float*)(ws + OFF_MODP); float* mod = (float*)(ws + OFF_MOD); float* nwsc = (float*)(ws + OFF_NWSC);
    for (int i = blockIdx.x * NTHREADS + otid(); i < 2 * 9 * MODW; i += gridDim.x * NTHREADS) {
        const int l = i / (9 * MODW), rem = i % (9 * MODW), mi = rem / MODW, col9 = rem % MODW, kidx = col9 / D, col = col9 % D; float s = KIN(I_ADAB)[l * MODW + col9];
#pragma unroll
        for (int ks = 0; ks < KSPLIT; ++ks) s += modp[(size_t)ks * 2 * 9 * MODW + i];
        mod[i] = s;
        if (kidx == 1 || kidx == 4 || kidx == 7) { const int j = kidx / 3; nwsc[((size_t)(l * 3 + j) * 9 + mi) * D + col] = KIN(I_NORMW)[(l * 3 + j) * D + col] * (1.f + s); } }
}
__device__ __forceinline__ void bias_phase(unsigned char* ws) {
    const int tid = otid(), lane = tid & 63, gw = blockIdx.x * NWAVES + (tid >> 6), NGW = gridDim.x * NWAVES;
    const float* mod = (const float*)(ws + OFF_MOD); float* bias = (float*)(ws + OFF_BIAS);
    constexpr int NR = 2 * NBIAS + INC;
    for (int ri = gw; ri < 2 * NR; ri += NGW) {
        const int l = ri / NR, r = ri % NR, j = r < NBIAS ? 0 : (r < NBIAS + INC ? 1 : 2), n = r - (j == 0 ? 0 : (j == 1 ? NBIAS : NBIAS + INC));
        const size_t woff = (j == 1) ? OFF_WIN + (size_t)l * SZ_WIN : OFF_WUP + (size_t)(l * 2 + (j >> 1)) * SZ_WUP;
        const bf16_t* wt = (const bf16_t*)(ws + woff) + (size_t)n * D + lane * 16;
        const u32x4 w0 = *(const u32x4*)wt, w1 = *(const u32x4*)(wt + 8);
        float wv[16];
#pragma unroll
        for (int k = 0; k < 4; ++k) { wv[2 * k] = bflo(w0[k]); wv[2 * k + 1] = bfhi(w0[k]); wv[8 + 2 * k] = bflo(w1[k]); wv[8 + 2 * k + 1] = bfhi(w1[k]); }
        float res[9];
#pragma unroll
        for (int mi = 0; mi < 9; ++mi) { const float* sh = mod + (size_t)(l * 9 + mi) * MODW + (3 * j) * D + lane * 16; float acc = 0.f;
#pragma unroll
            for (int q = 0; q < 4; ++q) { const f32x4 sv = *(const f32x4*)(sh + 4 * q); acc += (sv[0] * wv[4 * q] + sv[1] * wv[4 * q + 1]) + (sv[2] * wv[4 * q + 2] + sv[3] * wv[4 * q + 3]); }
            res[mi] = wave_sum(acc); }
        if (lane == 0) {
#pragma unroll
            for (int mi = 0; mi < 9; ++mi) bias[((size_t)(l * 3 + j) * 9 + mi) * NBIAS + n] = res[mi]; }
    }
}

__device__ __forceinline__ void norm0_phase(const float* src_lat, const float* src_ctx, const float* nwsc, bf16_t* U, float* rss, int nrows) {
    const int tid = otid(), lane = tid & 63, gw = blockIdx.x * NWAVES + (tid >> 6), NGW = gridDim.x * NWAVES;
    for (int row0 = gw; row0 < nrows; row0 += 2 * NGW) {
        f32x4 v[2][4]; int rw[2]; bool ok[2];
#pragma unroll
        for (int q = 0; q < 2; ++q) { const int row = row0 + q * NGW; ok[q] = row < nrows; rw[q] = ok[q] ? row : row0;
            const bool isl = rw[q] < NLAT;
            const f32x4* xr = (const f32x4*)((const char*)src_lat + (isl ? (size_t)rw[q] * D * 4 : ((const char*)src_ctx - (const char*)src_lat) + (size_t)(rw[q] - NLAT) * D * 4)) + lane;
#pragma unroll
            for (int j = 0; j < 4; ++j) v[q][j] = xr[64 * j]; }
#pragma unroll
        for (int q = 0; q < 2; ++q) { float ss = 0.f;
#pragma unroll
            for (int j = 0; j < 4; ++j) ss += (v[q][j].x * v[q][j].x + v[q][j].y * v[q][j].y) + (v[q][j].z * v[q][j].z + v[q][j].w * v[q][j].w);
            ss = wave_sum(ss);
            if (ok[q]) { const int row = rw[q], mi = row < NLAT ? row / SEQ : 8;
                if (lane == 0) rss[row] = ss;
                u32x2* o = (u32x2*)(U + (size_t)row * D) + lane;
#pragma unroll
                for (int j = 0; j < 4; ++j) { const int col = 4 * (lane + 64 * j);
                    const f32x4 uu = v[q][j] * *(const f32x4*)(nwsc + (size_t)mi * D + col);
                    u32x2 pk; pk.x = pk2(uu.x, uu.y); pk.y = pk2(uu.z, uu.w); o[64 * j] = pk; } } }
    }
}
__device__ __forceinline__ void final_norm_phase(float* out, const float* nw, const float* rss) {
    const int tid = otid(), lane = tid & 63, gw = blockIdx.x * NWAVES + (tid >> 6), NGW = gridDim.x * NWAVES;
    f32x4 wv[4];
#pragma unroll
    for (int j = 0; j < 4; ++j) wv[j] = *(const f32x4*)(nw + 4 * (lane + 64 * j));
    for (int row = gw; row < NLAT; row += 2 * NGW) {
        const int row2 = row + NGW; const bool has2 = row2 < NLAT; const int rb = has2 ? row2 : row;
        const u32x2* ha = (const u32x2*)((const bf16_t*)(out + (size_t)row * D) + D) + lane; const u32x2* hb = (const u32x2*)((const bf16_t*)(out + (size_t)rb * D) + D) + lane;
        u32x2 va[4], vb[4];
#pragma unroll
        for (int j = 0; j < 4; ++j) { va[j] = ha[64 * j]; vb[j] = hb[64 * j]; }
        const float ra = rsqrtf(rss[row] * (1.f / D) + EPS), r2 = rsqrtf(rss[rb] * (1.f / D) + EPS);
        asm volatile("s_waitcnt vmcnt(0)" ::: "memory");
        f32x4* oa = (f32x4*)(out + (size_t)row * D) + lane; f32x4* ob = (f32x4*)(out + (size_t)rb * D) + lane;
#pragma unroll
        for (int j = 0; j < 4; ++j) { oa[64 * j] = (f32x4){bflo(va[j].x), bfhi(va[j].x), bflo(va[j].y), bfhi(va[j].y)} * ra * wv[j];
            if (has2) ob[64 * j] = (f32x4){bflo(vb[j].x), bfhi(vb[j].x), bflo(vb[j].y), bfhi(vb[j].y)} * r2 * wv[j]; }
    }
}
__device__ __forceinline__ void a_phase(bf16_t* proj, const bf16_t* OF, const bf16_t* OB, const float* hgw, int nrows) {
    const int tid = otid(), lane = tid & 63, gw = blockIdx.x * NWAVES + (tid >> 6), NGW = gridDim.x * NWAVES;
    const f32x4 w0 = *(const f32x4*)(hgw + lane * 8), w1 = *(const f32x4*)(hgw + lane * 8 + 4);
    for (int row0 = gw; row0 < nrows; row0 += 2 * NGW) {
        u32x4 f[2], b[2], gg[2]; int rw[2]; bool ok[2];
#pragma unroll
        for (int q = 0; q < 2; ++q) { const int row = row0 + q * NGW; ok[q] = row < nrows; rw[q] = ok[q] ? row : row0;
            f[q] = *(const u32x4*)(OF + (size_t)rw[q] * HW + lane * 8); b[q] = *(const u32x4*)(OB + (size_t)rw[q] * HW + lane * 8);
            gg[q] = *(const u32x4*)(proj + (size_t)rw[q] * INC + PC_G + lane * 8); }
#pragma unroll
        for (int q = 0; q < 2; ++q) {
            float o[8], gv[8]; float ss = 0.f;
#pragma unroll
            for (int k = 0; k < 4; ++k) { o[2 * k] = bflo(f[q][k]) + bflo(b[q][k]); o[2 * k + 1] = bfhi(f[q][k]) + bfhi(b[q][k]); gv[2 * k] = bflo(gg[q][k]); gv[2 * k + 1] = bfhi(gg[q][k]); }
#pragma unroll
            for (int k = 0; k < 8; ++k) ss += o[k] * o[k];
            ss += __shfl_xor(ss, 1); ss += __shfl_xor(ss, 2); ss += __shfl_xor(ss, 4); ss += __shfl_xor(ss, 8);
            const float r = rsqrtf(ss * (1.f / 128.f) + EPS);
            float av[8];
#pragma unroll
            for (int k = 0; k < 4; ++k) { av[k] = o[k] * r * w0[k] * siluf(gv[k]); av[4 + k] = o[4 + k] * r * w1[k] * siluf(gv[4 + k]); }
            u32x4 w; w.x = pk2(av[0], av[1]); w.y = pk2(av[2], av[3]); w.z = pk2(av[4], av[5]); w.w = pk2(av[6], av[7]);
            if (ok[q]) *(u32x4*)(proj + (size_t)rw[q] * INC + PC_A + lane * 8) = w; }
    }
}

template <int MODE>
__device__ __forceinline__ void scan_phase(const bf16_t* proj, bf16_t* OF, bf16_t* OB, const float* lower_bounds, int l, LAS unsigned char* lds, float* segU, float* segD) {
    constexpr int C = 32, SD = 272, SS = 80;
    LAS unsigned char* QB = lds;
    LAS unsigned char* QC1 = QB + 32 * SD;
    LAS unsigned char* KD = QC1 + 16 * SD;
    LAS unsigned char* KE0 = KD + 32 * SD;
    LAS unsigned char* KST = KE0 + 16 * SD;
    LAS unsigned char* VT = KST + 128 * SS;
    LAS unsigned char* S0T = VT + 128 * SS;
    LAS unsigned char* ATT = S0T + 128 * SD;
    LAS float* TG = (LAS float*)(ATT + 32 * SS);
    LAS float* DEC = TG + 512;
    const int tid = otid(), lane = tid & 63, w = __builtin_amdgcn_readfirstlane(tid >> 6), q4 = lane >> 4, c = lane & 15;
    const int d = tid & 127, g = tid >> 7, sub = g >> 1, hf = g & 1;
    const int vs = tid & 31, veg = tid >> 5;
    constexpr int NS = (MODE == 0) ? NSEG - 1 : NSEG;
    for (int item = blockIdx.x; item < 64 * NS; item += gridDim.x) {
        const int seq = item / NS, sg = item - seq * NS, b = seq >> 3, h = (seq >> 1) & 3, dir = seq & 1, ch0 = sg * SEGCH;
        float lb = 0.f;
        if (l > 0) { const float a0 = lower_bounds[(dir * 2 + 0) * HW + h * 128 + d], a1 = lower_bounds[(dir * 2 + 1) * HW + h * 128 + d]; lb = 1.f / (1.f + __expf(a0 - a1)); }
        const float oml = 1.f - lb;
        bf16_t* O = (dir ? OB : OF) + h * 128;
        const bf16_t* pq = proj + PC_Q + h * 128 + d;
        const bf16_t* pz = proj + (dir ? PC_ZB : PC_ZF) + h * 128 + d;
        const bf16_t* pv = proj + PC_I + h * 128 + veg * 8;
        auto rowof = [&](int tt) -> size_t {
            if (tt < CTX) { const int idx = dir ? CTX - 1 - tt : tt; return (size_t)NLAT + b * CTX + idx; }
            const int li = tt - CTX, idx = dir ? SEQ - 1 - li : li; return (size_t)b * SEQ + idx; };
        f32x4 S[8];
#pragma unroll
        for (int i = 0; i < 8; ++i) S[i] = (f32x4){0.f, 0.f, 0.f, 0.f};
        float Ltot = 0.f;
        if (MODE == 1) {
            for (int j = 0; j < sg; ++j) {
                const f32x4* uj = (const f32x4*)(segU + ((size_t)(seq * (NSEG - 1) + j) * NTHREADS + tid) * 32);
                const f32x4 dj = *(const f32x4*)(segD + (size_t)(seq * (NSEG - 1) + j) * 128 + 16 * w + 4 * q4);
#pragma unroll
                for (int et = 0; et < 8; ++et) S[et] = S[et] * dj + uj[et];
            }
#pragma unroll
            for (int et = 0; et < 8; ++et) { u32x2 sw; sw.x = pk2(S[et][0], S[et][1]); sw.y = pk2(S[et][2], S[et][3]);
                *(LAS u32x2*)(S0T + (16 * et + c) * SD + (16 * w + 4 * q4) * 2) = sw; }
        }
        const long sINC = dir ? -(long)INC : (long)INC;
        bf16_t qn[8], zn[8]; u32x4 vn;
        { const long r0 = (long)(rowof(ch0 * C + 8 * g) * INC);
#pragma unroll
          for (int j = 0; j < 8; ++j) { if (MODE == 1) qn[j] = pq[r0 + j * sINC]; zn[j] = pz[r0 + j * sINC]; } }
        vn = *(const u32x4*)(pv + rowof(ch0 * C + vs) * INC);
        for (int ch = ch0; ch < ch0 + SEGCH; ++ch) {
            bf16_t qc[8], zc[8]; u32x4 vc = vn;
#pragma unroll
            for (int j = 0; j < 8; ++j) { if (MODE == 1) qc[j] = qn[j]; zc[j] = zn[j]; }
            if (ch + 1 < ch0 + SEGCH) { const long r0 = (long)(rowof((ch + 1) * C + 8 * g) * INC);
#pragma unroll
                for (int j = 0; j < 8; ++j) { if (MODE == 1) qn[j] = pq[r0 + j * sINC]; zn[j] = pz[r0 + j * sINC]; }
                vn = *(const u32x4*)(pv + rowof((ch + 1) * C + vs) * INC);
            }
            float qv[8], kk[8], cl[8]; float run = 0.f;
#pragma unroll
            for (int j = 0; j < 8; ++j) { float z = bf2f(zc[j]); z = fminf(fmaxf(z, -75.f), 75.f);
                const float ez = __expf(-z), sg = frcp(1.f + ez), f = lb + oml * sg;
                run += __log2f(f); cl[j] = run; kk[j] = oml * ez * sg; qv[j] = (MODE == 1) ? bf2f(qc[j]) : 0.f; }
            TG[g * 128 + d] = run;
            __syncthreads();
            {
                const float T0a = TG[d], T0b = TG[128 + d], T1a = TG[256 + d], T1b = TG[384 + d];
                const float T0 = T0a + T0b, T1 = T1a + T1b, eT0 = fexp2(T0), eT1 = fexp2(T1);
                const float off = hf ? (sub ? T1a : T0a) : 0.f;
                float ksv[8];
#pragma unroll
                for (int j = 0; j < 8; ++j) { const int t = 8 * g + j;
                    const float cc = fmaxf(off + cl[j], -108.f), e1 = fexp2(cc), r1 = frcp(e1);
                    const float qb = qv[j] * e1, kd = kk[j] * r1;
                    if (MODE == 1) { *(LAS bf16_t*)(QB + t * SD + d * 2) = f2bf(qb); *(LAS bf16_t*)(KD + t * SD + d * 2) = f2bf(kd); }
                    if (sub == 0) { if (MODE == 1) *(LAS bf16_t*)(KE0 + t * SD + d * 2) = f2bf(kd * eT0); ksv[j] = kd * eT0 * eT1; }
                    else { if (MODE == 1) *(LAS bf16_t*)(QC1 + (t - 16) * SD + d * 2) = f2bf(qb * eT0); ksv[j] = kd * eT1; } }
                Ltot += T0 + T1;
                u32x4 kw; kw.x = pk2(ksv[0], ksv[1]); kw.y = pk2(ksv[2], ksv[3]); kw.z = pk2(ksv[4], ksv[5]); kw.w = pk2(ksv[6], ksv[7]);
                *(LAS u32x4*)(KST + d * SS + (8 * g) * 2) = kw;
                if (g == 0) DEC[d] = eT0 * eT1;
#pragma unroll
                for (int k = 0; k < 4; ++k) { *(LAS bf16_t*)(VT + (veg * 8 + 2 * k) * SS + vs * 2) = (bf16_t)(vc[k] & 0xffffu); *(LAS bf16_t*)(VT + (veg * 8 + 2 * k + 1) * SS + vs * 2) = (bf16_t)(vc[k] >> 16); }
            }
            __syncthreads();
            f32x4 o0 = (f32x4){0.f, 0.f, 0.f, 0.f}, o1 = o0;
            if (MODE == 1) {
#pragma unroll
            for (int kq = 0; kq < 4; ++kq) { const int ko = (32 * kq + 8 * q4) * 2;
                const bf16x8 av = *(const LAS bf16x8*)(S0T + (16 * w + c) * SD + ko), b0 = *(const LAS bf16x8*)(QB + c * SD + ko), b1 = *(const LAS bf16x8*)(QC1 + c * SD + ko);
                o0 = __builtin_amdgcn_mfma_f32_16x16x32_bf16(av, b0, o0, 0, 0, 0); o1 = __builtin_amdgcn_mfma_f32_16x16x32_bf16(av, b1, o1, 0, 0, 0); }
            if (w < 3) {
                LAS unsigned char* KM = (w == 1) ? KE0 : (w == 0 ? KD : KD + 16 * SD);
                LAS unsigned char* QM = (w == 0) ? QB : QB + 16 * SD;
                f32x4 at = (f32x4){0.f, 0.f, 0.f, 0.f};
#pragma unroll
                for (int kq = 0; kq < 4; ++kq) { const int ko = (32 * kq + 8 * q4) * 2;
                    const bf16x8 av = *(const LAS bf16x8*)(KM + c * SD + ko), bv = *(const LAS bf16x8*)(QM + c * SD + ko);
                    at = __builtin_amdgcn_mfma_f32_16x16x32_bf16(av, bv, at, 0, 0, 0); }
                if (w != 1) {
#pragma unroll
                    for (int r = 0; r < 4; ++r) if (4 * q4 + r > c) at[r] = 0.f;
                }
                const int t0 = (w == 0) ? 0 : 16, s0 = (w == 2) ? 16 : 0;
                u32x2 pw; pw.x = pk2(at[0], at[1]); pw.y = pk2(at[2], at[3]);
                *(LAS u32x2*)(ATT + (t0 + c) * SS + (s0 + 4 * q4) * 2) = pw;
            } else if (w == 3) {
                *(LAS u32x2*)(ATT + c * SS + (16 + 4 * q4) * 2) = (u32x2){0u, 0u};
            }
            __syncthreads();
            }
            if (MODE == 1) {
                const bf16x8 av = *(const LAS bf16x8*)(VT + (16 * w + c) * SS + 8 * q4 * 2);
                const bf16x8 b0 = *(const LAS bf16x8*)(ATT + c * SS + 8 * q4 * 2), b1 = *(const LAS bf16x8*)(ATT + (16 + c) * SS + 8 * q4 * 2);
                o0 = __builtin_amdgcn_mfma_f32_16x16x32_bf16(av, b0, o0, 0, 0, 0); o1 = __builtin_amdgcn_mfma_f32_16x16x32_bf16(av, b1, o1, 0, 0, 0);
                u32x2 w0, w1; w0.x = pk2(o0[0], o0[1]); w0.y = pk2(o0[2], o0[3]); w1.x = pk2(o1[0], o1[1]); w1.y = pk2(o1[2], o1[3]);
                { bf16_t* op = O + rowof(ch * C + c) * HW + 16 * w + 4 * q4; const long s16 = dir ? -16L * HW : 16L * HW;
                  *(u32x2*)op = w0; *(u32x2*)(op + s16) = w1; }
            }
            {
                const bf16x8 ak = *(const LAS bf16x8*)(KST + (16 * w + c) * SS + 8 * q4 * 2);
                const f32x4 dc = *(const LAS f32x4*)(DEC + 16 * w + 4 * q4);
#pragma unroll
                for (int et = 0; et < 8; ++et) { const bf16x8 bv = *(const LAS bf16x8*)(VT + (16 * et + c) * SS + 8 * q4 * 2);
                    S[et] = __builtin_amdgcn_mfma_f32_16x16x32_bf16(ak, bv, S[et] * dc, 0, 0, 0);
                    if (MODE == 1) { u32x2 sw; sw.x = pk2(S[et][0], S[et][1]); sw.y = pk2(S[et][2], S[et][3]);
                        *(LAS u32x2*)(S0T + (16 * et + c) * SD + (16 * w + 4 * q4) * 2) = sw; } }
            }
        }
        if (MODE == 0) {
            f32x4* uo = (f32x4*)(segU + ((size_t)(seq * (NSEG - 1) + sg) * NTHREADS + tid) * 32);
#pragma unroll
            for (int et = 0; et < 8; ++et) uo[et] = S[et];
            if (g == 0) segD[(size_t)(seq * (NSEG - 1) + sg) * 128 + d] = fexp2(Ltot);
        }
        __syncthreads();
    }
}

__device__ __forceinline__ void scan_summary(const bf16_t* proj, const float* lower_bounds, int l, LAS unsigned char* lds, float* segU, float* segD) {
    constexpr int C = 64, SS = 144, NCHS = SEGCH / 2;
    LAS unsigned char* KST = lds;
    LAS unsigned char* VT = KST + 128 * SS;
    LAS float* TG = (LAS float*)(VT + 128 * SS);
    LAS float* DEC = TG + 512;
    const int tid = otid(), lane = tid & 63, w = __builtin_amdgcn_readfirstlane(tid >> 6), q4 = lane >> 4, c = lane & 15;
    const int d = tid & 127, g = tid >> 7;
    for (int item = blockIdx.x; item < 64 * (NSEG - 1); item += gridDim.x) {
        const int seq = item / (NSEG - 1), sg = item - seq * (NSEG - 1), b = seq >> 3, h = (seq >> 1) & 3, dir = seq & 1, t0 = sg * SEGCH * 32;
        float lb = 0.f;
        if (l > 0) { const float a0 = lower_bounds[(dir * 2 + 0) * HW + h * 128 + d], a1 = lower_bounds[(dir * 2 + 1) * HW + h * 128 + d]; lb = 1.f / (1.f + __expf(a0 - a1)); }
        const float oml = 1.f - lb;
        const bf16_t* pz = proj + (dir ? PC_ZB : PC_ZF) + h * 128 + d;
        const bf16_t* pv = proj + PC_I + h * 128;
        auto rowof = [&](int tt) -> size_t {
            if (tt < CTX) { const int idx = dir ? CTX - 1 - tt : tt; return (size_t)NLAT + b * CTX + idx; }
            const int li = tt - CTX, idx = dir ? SEQ - 1 - li : li; return (size_t)b * SEQ + idx; };
        f32x4 S[8];
#pragma unroll
        for (int i = 0; i < 8; ++i) S[i] = (f32x4){0.f, 0.f, 0.f, 0.f};
        float Ltot = 0.f;
        const long sINC = dir ? -(long)INC : (long)INC;
        bf16_t zn[16]; u32x4 vn[2];
        { const long r0 = (long)(rowof(t0 + 16 * g) * INC);
#pragma unroll
          for (int j = 0; j < 16; ++j) zn[j] = pz[r0 + j * sINC]; }
#pragma unroll
        for (int i = 0; i < 2; ++i) { const int idx = tid + NTHREADS * i; vn[i] = *(const u32x4*)(pv + rowof(t0 + (idx & 63)) * INC + (idx >> 6) * 8); }
        for (int ch = 0; ch < NCHS; ++ch) {
            bf16_t zc[16]; u32x4 vc[2] = {vn[0], vn[1]};
#pragma unroll
            for (int j = 0; j < 16; ++j) zc[j] = zn[j];
            if (ch + 1 < NCHS) { const int tn = t0 + (ch + 1) * C; const long r0 = (long)(rowof(tn + 16 * g) * INC);
#pragma unroll
                for (int j = 0; j < 16; ++j) zn[j] = pz[r0 + j * sINC];
#pragma unroll
                for (int i = 0; i < 2; ++i) { const int idx = tid + NTHREADS * i; vn[i] = *(const u32x4*)(pv + rowof(tn + (idx & 63)) * INC + (idx >> 6) * 8); } }
            float kk[16], cl[16]; float run = 0.f;
#pragma unroll
            for (int j = 0; j < 16; ++j) { float z = bf2f(zc[j]); z = fminf(fmaxf(z, -75.f), 75.f);
                const float ez = __expf(-z), sg2 = frcp(1.f + ez), f = lb + oml * sg2;
                run += __log2f(f); cl[j] = run; kk[j] = oml * ez * sg2; }
            TG[g * 128 + d] = run;
            __syncthreads();
            {
                const float T0 = TG[d], T1 = TG[128 + d], T2 = TG[256 + d], T3 = TG[384 + d];
                const float T = (T0 + T1) + (T2 + T3);
                const float off = (g > 0 ? T0 : 0.f) + (g > 1 ? T1 : 0.f) + (g > 2 ? T2 : 0.f);
                float ks[16];
#pragma unroll
                for (int j = 0; j < 16; ++j) ks[j] = kk[j] * fexp2(T - (off + cl[j]));
                u32x4 k0, k1; k0.x = pk2(ks[0], ks[1]); k0.y = pk2(ks[2], ks[3]); k0.z = pk2(ks[4], ks[5]); k0.w = pk2(ks[6], ks[7]);
                k1.x = pk2(ks[8], ks[9]); k1.y = pk2(ks[10], ks[11]); k1.z = pk2(ks[12], ks[13]); k1.w = pk2(ks[14], ks[15]);
                *(LAS u32x4*)(KST + d * SS + (16 * g) * 2) = k0; *(LAS u32x4*)(KST + d * SS + (16 * g + 8) * 2) = k1;
                if (g == 0) DEC[d] = fexp2(T);
                Ltot += T;
#pragma unroll
                for (int i = 0; i < 2; ++i) { const int idx = tid + NTHREADS * i, vs = idx & 63, veg = idx >> 6;
#pragma unroll
                    for (int k = 0; k < 4; ++k) { *(LAS bf16_t*)(VT + (veg * 8 + 2 * k) * SS + vs * 2) = (bf16_t)(vc[i][k] & 0xffffu); *(LAS bf16_t*)(VT + (veg * 8 + 2 * k + 1) * SS + vs * 2) = (bf16_t)(vc[i][k] >> 16); } }
            }
            __syncthreads();
            {
                const bf16x8 ak0 = *(const LAS bf16x8*)(KST + (16 * w + c) * SS + 8 * q4 * 2), ak1 = *(const LAS bf16x8*)(KST + (16 * w + c) * SS + (32 + 8 * q4) * 2);
                const f32x4 dc = *(const LAS f32x4*)(DEC + 16 * w + 4 * q4);
#pragma unroll
                for (int et = 0; et < 8; ++et) { const bf16x8 b0 = *(const LAS bf16x8*)(VT + (16 * et + c) * SS + 8 * q4 * 2), b1 = *(const LAS bf16x8*)(VT + (16 * et + c) * SS + (32 + 8 * q4) * 2);
                    S[et] = __builtin_amdgcn_mfma_f32_16x16x32_bf16(ak0, b0, S[et] * dc, 0, 0, 0);
                    S[et] = __builtin_amdgcn_mfma_f32_16x16x32_bf16(ak1, b1, S[et], 0, 0, 0); }
            }
        }
        f32x4* uo = (f32x4*)(segU + ((size_t)(seq * (NSEG - 1) + sg) * NTHREADS + tid) * 32);
#pragma unroll
        for (int et = 0; et < 8; ++et) uo[et] = S[et];
        if (g == 0) segD[(size_t)(seq * (NSEG - 1) + sg) * 128 + d] = fexp2(Ltot);
        __syncthreads();
    }
}

__device__ __forceinline__ void pool_phase(bf16_t* proj, bool do_ctx, LAS unsigned char* lds) {
    const int tid = otid(), c = tid, g = c >> 7, hw = 1 << g;
    {
        const int lane = tid & 63, gw = blockIdx.x * NWAVES + (tid >> 6), NGW = gridDim.x * NWAVES;
        for (int wi = gw; wi < NB * 4 * 8 * 16; wi += NGW) {
            const int k2 = wi >> 11, idx = wi & 2047, chunk = idx & 15, strip = (idx >> 4) & 7, gq = (idx >> 7) & 3, gg = k2 ? 3 - gq : gq, b = (idx >> 9) + 4 * k2, hh = 1 << gg, r0 = strip * 16;
            bf16_t* base = proj + ((size_t)b * SEQ + lane) * INC + gg * 128 + chunk * 8;
            float V[8];
#pragma unroll
            for (int k = 0; k < 8; ++k) V[k] = 0.f;
            const u32x4 zero4 = (u32x4){0u, 0u, 0u, 0u};
            auto ldrow = [&](int r) -> u32x4 { return (r >= 0 && r < 128) ? *(const u32x4*)(base + (size_t)r * 64 * INC + PC_PV) : zero4; };
            auto acc8 = [&](const u32x4& x, float sgn) {
#pragma unroll
                for (int k = 0; k < 4; ++k) { V[2 * k] += sgn * bflo(x[k]); V[2 * k + 1] += sgn * bfhi(x[k]); } };
            for (int i0 = 0; i0 < 2 * hh - 1; i0 += 4) { u32x4 t[4];
#pragma unroll
                for (int i = 0; i < 4; ++i) t[i] = (i0 + i < 2 * hh - 1) ? ldrow(r0 - hh + i0 + i) : zero4;
#pragma unroll
                for (int i = 0; i < 4; ++i) acc8(t[i], 1.f); }
            const int c_lo = lane - hh < 0 ? 0 : lane - hh, c_hi = lane + hh > 64 ? 64 : lane + hh;
            u32x4 nnew = ldrow(r0 + hh - 1), nctr = ldrow(r0), nold = ldrow(r0 - hh);
            for (int r = r0; r < r0 + 16; ++r) {
                const u32x4 xnew = nnew, xc = nctr, xold = nold;
                if (r + 1 < r0 + 16) { nnew = ldrow(r + hh); nctr = ldrow(r + 1); nold = ldrow(r + 1 - hh); }
                acc8(xnew, 1.f);
                const int r_lo = r - hh < 0 ? 0 : r - hh, r_hi = r + hh > 128 ? 128 : r + hh;
                const float inv = frcp((float)((r_hi - r_lo) * (c_hi - c_lo)));
                float o[8], F[8], Gs[8];
#pragma unroll
                for (int k = 0; k < 8; ++k) { F[k] = V[k]; Gs[k] = V[k]; }
                for (int dl = 1; dl < hh; dl <<= 1) { const bool fok = lane + dl < 64, gok = lane - dl >= 0;
#pragma unroll
                    for (int k = 0; k < 8; ++k) { const float fd = __shfl_down(F[k], dl), gu = __shfl_up(Gs[k], dl); F[k] += fok ? fd : 0.f; Gs[k] += gok ? gu : 0.f; } }
#pragma unroll
                for (int k = 0; k < 8; ++k) {
                    const float gp = __shfl_up(Gs[k], 1);
                    const float box = F[k] + (lane >= 1 ? gp : 0.f);
                    const float seg = (k & 1) ? bfhi(xc[k >> 1]) : bflo(xc[k >> 1]);
                    o[k] = box * inv - seg; }
                u32x4 w; w.x = pk2(o[0], o[1]); w.y = pk2(o[2], o[3]); w.z = pk2(o[4], o[5]); w.w = pk2(o[6], o[7]);
                *(u32x4*)(base + (size_t)r * 64 * INC + PC_D) = w;
                acc8(xold, -1.f);
            }
        }
    }
    if (do_ctx) {
        for (int item = blockIdx.x; item < NB * (CTX / 64); item += gridDim.x) {
            const int b = item >> 2, t0 = (item & 3) * 64;
            for (int t = 0; t < 64; ++t) { const int tok = t0 + t, lo = tok - hw < 0 ? 0 : tok - hw, hi = tok + hw > CTX ? CTX : tok + hw;
                bf16_t* base = proj + ((size_t)NLAT + b * CTX) * INC; float s = 0.f;
                for (int tt = lo; tt < hi; ++tt) s += bf2f(base[(size_t)tt * INC + PC_PV + c]);
                base[(size_t)tok * INC + PC_D + c] = f2bf(s / (float)(hi - lo) - bf2f(base[(size_t)tok * INC + PC_PV + c])); }
        }
    }
}

__global__ void __launch_bounds__(NTHREADS, 2) mega(Args a) {
    extern __shared__ __attribute__((aligned(16))) unsigned char lds_raw[];
    LAS unsigned char* lds = (LAS unsigned char*)lds_raw;
    cg::grid_group grid = cg::this_grid();
    const int G = gridDim.x, bx = blockIdx.x;
    int ph = 0; const int lo = a.lo, hi = a.hi;
    volatile LAS unsigned* stw = (volatile LAS unsigned*)(lds + LDS_MAIN);
    if (threadIdx.x < 4) stw[threadIdx.x] = 0u;
    __syncthreads();
    const XcdBarrier xbar = xcd_barrier_post((unsigned*)(KWS + OFF_BAR), stw);
#define PH_BEGIN if (ph >= lo && ph < hi) {
#define PH_END } if (ph >= lo && ph + 1 < hi) { if (lo > hi) grid.sync(); else xcd_barrier(xbar); } ++ph;
#define W_U ((bf16_t*)(KWS + OFF_U))
#define W_OF W_U
#define W_OB (W_U + (size_t)MROWS * HW)
#define W_PROJ ((bf16_t*)(KWS + OFF_PROJ))
#define W_ACT W_PROJ
#define W_MERGED (W_PROJ + 1024)
#define W_HC ((bf16_t*)(KWS + OFF_HC) + D)
#define W_HLAT ((bf16_t*)KOUT + D)
#define W_MODL ((const float*)(KWS + OFF_MOD) + (size_t)l * 9 * MODW)
#define W_RSS(j) ((float*)(KWS + OFF_RSS) + (size_t)(l * 3 + (j)) * MROWS)
#define W_NWSC(j) ((const float*)(KWS + OFF_NWSC) + (size_t)(l * 3 + (j)) * 9 * D)
#define W_BIAS(j) ((const float*)(KWS + OFF_BIAS) + (size_t)(l * 3 + (j)) * 9 * NBIAS)

    PH_BEGIN prologue_a(lds); PH_END
    PH_BEGIN prologue_b(); PH_END
    PH_BEGIN { const int l = 0; norm0_phase(KIN(I_X), KIN(I_CTX), W_NWSC(0), W_U, W_RSS(0), MROWS); bias_phase(KWS); } PH_END

    for (int l = 0; l < 2; ++l) {
        const bool last = (l == 1);
        const int nrows = last ? NLAT : MROWS;
        PH_BEGIN { pg8::Gemm g{(const char*)W_U, (const char*)(KWS + OFF_WUP + (size_t)(l * 2) * SZ_WUP), 0, 0, D, D};
            pg8::Sched<1> S; S.init(MROWS, 2 * DFF, G, bx); pg8::EpiUp E{W_ACT, W_RSS(0), W_BIAS(0)}; pg8::gemm_phase(lds, g, S, E); } PH_END
        PH_BEGIN { pg8::Gemm g{(const char*)W_ACT, (const char*)(KWS + OFF_WDN + (size_t)(l * 2) * SZ_WDN), 0, 0, DFF, DFF};
            bf16_t* h_lat = W_HLAT; bf16_t* h_ctx = W_HC; const long dctx = (char*)h_ctx - (char*)h_lat;
            pg8::Sched<1> S; S.init(MROWS, D, G, bx, 1);
            if (l == 0) { const float* xl = KIN(I_X); pg8::EpiRes<true, true> E{xl, (const char*)KIN(I_CTX) - (const char*)xl, h_lat, dctx, W_MODL + 2 * D, W_U, W_NWSC(1), W_RSS(1)}; pg8::gemm_phase(lds, g, S, E); }
            else { pg8::EpiRes<true, false> E{h_lat, dctx, h_lat, dctx, W_MODL + 2 * D, W_U, W_NWSC(1), W_RSS(1)}; pg8::gemm_phase(lds, g, S, E); } } PH_END
        PH_BEGIN { pg8::Gemm g{(const char*)W_U, (const char*)(KWS + OFF_WIN + (size_t)l * SZ_WIN), 0, 0, D, D};
            pg8::Sched<1> S; S.init(MROWS, INC, G, bx); pg8::EpiProj E{W_PROJ, INC, W_RSS(1), W_BIAS(1)}; pg8::gemm_phase(lds, g, S, E); } PH_END
        PH_BEGIN { unsigned char* ws = KWS; scan_summary(W_PROJ, KIN(I_LB), l, lds, (float*)(ws + OFF_SEGU), (float*)(ws + OFF_SEGD)); } PH_END
        PH_BEGIN { unsigned char* ws = KWS; scan_phase<1>(W_PROJ, W_OF, W_OB, KIN(I_LB), l, lds, (float*)(ws + OFF_SEGU), (float*)(ws + OFF_SEGD)); } PH_END
        PH_BEGIN pool_phase(W_PROJ, !last, lds); a_phase(W_PROJ, W_OF, W_OB, KIN(I_HGW) + l * HW, nrows); PH_END
        PH_BEGIN { pg8::Gemm g{(const char*)(W_PROJ + PC_A), (const char*)(KWS + OFF_WA + (size_t)l * SZ_WA), ((long)PC_D - (long)PC_A) * 2, (long)OFF_WE - (long)OFF_WA, INC, HW};
            pg8::Sched<2> S; S.init(nrows, D, G, bx); pg8::EpiMerge E{W_PROJ, W_MERGED, INC}; pg8::gemm_phase(lds, g, S, E); } PH_END
        PH_BEGIN { pg8::Gemm g{(const char*)W_MERGED, (const char*)(KWS + OFF_WOUT + (size_t)l * SZ_WOUT), 0, 0, INC, D};
            bf16_t* h_lat = W_HLAT; bf16_t* h_ctx = W_HC; const long dctx = (char*)h_ctx - (char*)h_lat;
            pg8::Sched<1> S; S.init(nrows, D, G, bx, 1); pg8::EpiRes<false, false> E{h_lat, dctx, h_lat, dctx, W_MODL + 5 * D, W_U, W_NWSC(2), W_RSS(2)}; pg8::gemm_phase(lds, g, S, E); } PH_END
        PH_BEGIN { pg8::Gemm g{(const char*)W_U, (const char*)(KWS + OFF_WUP + (size_t)(l * 2 + 1) * SZ_WUP), 0, 0, D, D};
            pg8::Sched<1> S; S.init(nrows, 2 * DFF, G, bx); pg8::EpiUp E{W_ACT, W_RSS(2), W_BIAS(2)}; pg8::gemm_phase(lds, g, S, E); } PH_END
        PH_BEGIN { pg8::Gemm g{(const char*)W_ACT, (const char*)(KWS + OFF_WDN + (size_t)(l * 2 + 1) * SZ_WDN), 0, 0, DFF, DFF};
            bf16_t* h_lat = W_HLAT; bf16_t* h_ctx = W_HC; const long dctx = (char*)h_ctx - (char*)h_lat;
            pg8::Sched<1> S; S.init(nrows, D, G, bx, 1);
            if (last) { pg8::EpiRes<true, false, false> E{h_lat, dctx, h_lat, dctx, W_MODL + 8 * D, W_U, W_NWSC(3), W_RSS(3)}; pg8::gemm_phase(lds, g, S, E); }
            else { pg8::EpiRes<true, false> E{h_lat, dctx, h_lat, dctx, W_MODL + 8 * D, W_U, W_NWSC(3), W_RSS(3)}; pg8::gemm_phase(lds, g, S, E); } } PH_END
    }
    PH_BEGIN final_norm_phase(KOUT, KIN(I_FNW), (const float*)(KWS + OFF_RSS) + (size_t)6 * MROWS); PH_END
#undef PH_BEGIN
#undef PH_END
}

extern "C" void kernel_launch(void* const* d_in, const int* in_sizes, int n_in, void* d_out, int out_size, void* d_ws, size_t ws_size, hipStream_t stream) {
    static int grid = 0;
    if (grid == 0) {
        if (n_in != 19 || out_size != NLAT * D || ws_size < WS_END) { fprintf(stderr, "kernel_launch: unexpected shapes (n_in %d out %d ws %zu need %zu)\n", n_in, out_size, ws_size, (size_t)WS_END); grid = -1; return; }
        int dev = 0, cus = 0, per_cu = 0;
        hipGetDevice(&dev); hipDeviceGetAttribute(&cus, hipDeviceAttributeMultiprocessorCount, dev);
        if (hipFuncSetAttribute((const void*)mega, hipFuncAttributeMaxDynamicSharedMemorySize, LDS_BYTES) != hipSuccess) { fprintf(stderr, "kernel_launch: hipFuncSetAttribute failed\n"); grid = -1; return; }
        if (hipOccupancyMaxActiveBlocksPerMultiprocessor(&per_cu, (const void*)mega, NTHREADS, LDS_BYTES) != hipSuccess || per_cu < 1) { fprintf(stderr, "kernel_launch: occupancy query gave %d\n", per_cu); per_cu = 1; }
        (void)hipGetLastError();
        grid = cus * per_cu;
        fprintf(stderr, "kernel_launch: grid %d (cus %d x %d), ws %zu\n", grid, cus, per_cu, ws_size);
    }
    if (grid < 0) return;
    if (hipMemsetAsync((unsigned char*)d_ws + OFF_BAR, 0, SZ_BAR, stream) != hipSuccess) { fprintf(stderr, "kernel_launch: memset of barrier words failed\n"); return; }
    Args a{};
    for (int i = 0; i < 19; ++i) a.in[i] = (const float*)d_in[i];
    a.out = (float*)d_out; a.ws = (unsigned char*)d_ws; a.lo = 0; a.hi = 1000;
    void* args[] = {&a};
    hipError_t e = hipLaunchCooperativeKernel((const void*)mega, dim3(grid), dim3(NTHREADS), args, LDS_BYTES, stream);
    if (e != hipSuccess) fprintf(stderr, "kernel_launch: cooperative launch failed: %s (grid %d)\n", hipGetErrorString(e), grid);
}
```
